# Optimizing an MI355X kernel written in HIP

```python
import jax, jax.numpy as jnp
from jax import lax
import numpy as np

D_MODEL = 1024
BATCH = 4
SEQ = 4096
DEPTH = 2

GRID_W = 64
D_GROUP = 256
N_GROUPS = 4
D_MIX = N_GROUPS * D_GROUP
HEAD_DIM = 64
CONV_A_WIDTH = 31
CONV_B_WIDTH = 3
SWA_Q_HEADS = D_GROUP // HEAD_DIM
SWA_KV_HEADS = 2
SWA_WINDOW = 128
SWA_BLOCK = 128
NA_HEADS = D_GROUP // HEAD_DIM
NA_KH_MAX = 8
NA_KW = 16
ROPE_THETA = 10000.0
EPS = 1e-6
NEG_INF = -1e30

SPLIT_SIZES = (
    D_GROUP, D_GROUP, D_GROUP,
    D_GROUP, D_GROUP, D_GROUP, D_GROUP,
    SWA_Q_HEADS * HEAD_DIM, SWA_KV_HEADS * HEAD_DIM,
    SWA_KV_HEADS * HEAD_DIM, D_GROUP,
    NA_HEADS * HEAD_DIM, NA_HEADS * HEAD_DIM,
    NA_HEADS * HEAD_DIM, D_GROUP,
)
D_IN = sum(SPLIT_SIZES)

kernel_name = "hymba_style_bidir_hybrid_encoder"


def rmsnorm(x, g):
    x32 = x.astype(jnp.float32)
    y = x32 * lax.rsqrt(jnp.mean(x32 * x32, axis=-1, keepdims=True) + EPS)
    return y.astype(x.dtype) * g


def layernorm(x, g, b):
    x32 = x.astype(jnp.float32)
    mu = jnp.mean(x32, axis=-1, keepdims=True)
    xc = x32 - mu
    y = xc * lax.rsqrt(jnp.mean(xc * xc, axis=-1, keepdims=True) + EPS)
    return y.astype(x.dtype) * g + b


def depthwise_conv(x, w):
    width, ch = w.shape
    pad = (width - 1) // 2
    return lax.conv_general_dilated(
        x, w[:, None, :], window_strides=(1,), padding=[(pad, pad)],
        dimension_numbers=("NWC", "WIO", "NWC"), feature_group_count=ch)


def rope(x, pos):
    d = x.shape[-1]
    inv_freq = ROPE_THETA ** (-jnp.arange(0, d, 2, dtype=jnp.float32) / d)
    ang = pos[:, None] * inv_freq[None, :]
    cos = jnp.cos(ang)[None, :, None, :].astype(x.dtype)
    sin = jnp.sin(ang)[None, :, None, :].astype(x.dtype)
    x1, x2 = x[..., : d // 2], x[..., d // 2:]
    return jnp.concatenate([x1 * cos - x2 * sin, x2 * cos + x1 * sin], axis=-1)


def conformer_conv(u, v, conv_w, conv_b, ln_g, ln_b):
    h = u * jax.nn.sigmoid(v)
    h = depthwise_conv(h, conv_w) + conv_b
    h = layernorm(h, ln_g, ln_b)
    return jax.nn.silu(h)


def short_gated_conv(bg, cg, xv, conv_w):
    return bg * depthwise_conv(cg * xv, conv_w)


def window_gqa(q, k, v, sink):
    b, s, hq, d = q.shape
    hkv = k.shape[2]
    g = hq // hkv
    nb = s // SWA_BLOCK
    pos = jnp.arange(s, dtype=jnp.float32)
    q = rope(q, pos)
    k = rope(k, pos)
    qb = q.reshape(b, nb, SWA_BLOCK, hkv, g, d)
    pad = ((0, 0), (SWA_BLOCK, SWA_BLOCK), (0, 0), (0, 0))
    kp = jnp.pad(k, pad).reshape(b, nb + 2, SWA_BLOCK, hkv, d)
    vp = jnp.pad(v, pad).reshape(b, nb + 2, SWA_BLOCK, hkv, d)
    kw = jnp.concatenate([kp[:, :-2], kp[:, 1:-1], kp[:, 2:]], axis=2)
    vw = jnp.concatenate([vp[:, :-2], vp[:, 1:-1], vp[:, 2:]], axis=2)
    scores = jnp.einsum("bnqhgd,bnkhd->bnhgqk", qb, kw).astype(jnp.float32) * (d ** -0.5)
    blk = jnp.arange(nb)[:, None, None]
    qpos = blk * SWA_BLOCK + jnp.arange(SWA_BLOCK)[None, :, None]
    kpos = (blk - 1) * SWA_BLOCK + jnp.arange(3 * SWA_BLOCK)[None, None, :]
    valid = (jnp.abs(kpos - qpos) <= SWA_WINDOW) & (kpos >= 0) & (kpos < s)
    scores = jnp.where(valid[None, :, None, None], scores, NEG_INF)
    sink_col = jnp.broadcast_to(sink.astype(jnp.float32).reshape(1, 1, hkv, g, 1, 1),
                                scores.shape[:-1] + (1,))
    p = jax.nn.softmax(jnp.concatenate([scores, sink_col], axis=-1), axis=-1)[..., :-1]
    o = jnp.einsum("bnhgqk,bnkhd->bnqhgd", p.astype(v.dtype), vw)
    return o.reshape(b, s, hq * d)


def neighborhood_attn(q, k, v, rpb):
    b, s, h, d = q.shape
    rows = s // GRID_W
    kh = min(NA_KH_MAX, rows)
    r = jnp.arange(rows)
    r0 = jnp.clip(r - kh // 2, 0, rows - kh)
    row_idx = r0[:, None] + jnp.arange(kh)[None, :]
    qg = q.reshape(b, rows, GRID_W, h, d)
    kg = jnp.take(k.reshape(b, rows, GRID_W, h, d), row_idx, axis=1)
    vg = jnp.take(v.reshape(b, rows, GRID_W, h, d), row_idx, axis=1)
    scores = jnp.einsum("brqhd,brikhd->brhqik", qg, kg).astype(jnp.float32) * (d ** -0.5)
    c = jnp.arange(GRID_W)
    c0 = jnp.clip(c - NA_KW // 2, 0, GRID_W - NA_KW)
    col_ok = (c[None, :] >= c0[:, None]) & (c[None, :] < c0[:, None] + NA_KW)
    dr = row_idx - r[:, None] + (NA_KH_MAX - 1)
    dc = jnp.clip(c[None, :] - c[:, None], -(NA_KW - 1), NA_KW - 1) + (NA_KW - 1)
    bias = jnp.take(rpb[:, dr], dc, axis=-1)
    bias = bias.transpose(1, 0, 3, 2, 4).astype(jnp.float32)
    scores = jnp.where(col_ok[:, None, :], scores + bias[None], NEG_INF)
    p = jax.nn.softmax(scores.reshape(b, rows, h, GRID_W, kh * GRID_W), axis=-1)
    p = p.reshape(scores.shape).astype(v.dtype)
    o = jnp.einsum("brhqik,brikhd->brqhd", p, vg)
    return o.reshape(b, s, h * d)


def hybrid_layer(x, norm_g, w_in, w_out, conv_a_w, conv_a_b, ln_a_g, ln_a_b,
                 conv_b_w, swa_sink, na_rpb):
    b, s, _ = x.shape
    h = rmsnorm(x, norm_g)
    proj = jnp.einsum("bsd,de->bse", h, w_in)
    split_points = np.cumsum(SPLIT_SIZES)[:-1].tolist()
    (a_u, a_v, a_z,
     b_b, b_c, b_x, b_z,
     c_q, c_k, c_v, c_z,
     d_q, d_k, d_v, d_z) = jnp.split(proj, split_points, axis=-1)
    y_a = conformer_conv(a_u, a_v, conv_a_w, conv_a_b, ln_a_g, ln_a_b) * jax.nn.silu(a_z)
    y_b = short_gated_conv(b_b, b_c, b_x, conv_b_w) * jax.nn.silu(b_z)
    y_c = window_gqa(c_q.reshape(b, s, SWA_Q_HEADS, HEAD_DIM),
                     c_k.reshape(b, s, SWA_KV_HEADS, HEAD_DIM),
                     c_v.reshape(b, s, SWA_KV_HEADS, HEAD_DIM), swa_sink) * jax.nn.silu(c_z)
    y_d = neighborhood_attn(d_q.reshape(b, s, NA_HEADS, HEAD_DIM),
                            d_k.reshape(b, s, NA_HEADS, HEAD_DIM),
                            d_v.reshape(b, s, NA_HEADS, HEAD_DIM), na_rpb) * jax.nn.silu(d_z)
    y = jnp.concatenate([y_a, y_b, y_c, y_d], axis=-1)
    return x + jnp.einsum("bse,ed->bsd", y, w_out)


def setup_inputs(seed: int = 0) -> dict:
    key = jax.random.key(seed)
    ks = jax.random.split(key, 12)
    f32 = jnp.float32
    x = jax.random.normal(ks[0], (BATCH, SEQ, D_MODEL), f32)
    norm_g = 1.0 + 0.05 * jax.random.normal(ks[1], (DEPTH, D_MODEL), f32)
    w_in = jax.random.normal(ks[2], (DEPTH, D_MODEL, D_IN), f32) * D_MODEL ** -0.5
    w_out = jax.random.normal(ks[3], (DEPTH, D_MIX, D_MODEL), f32) * D_MIX ** -0.5
    conv_a_w = jax.random.normal(ks[4], (DEPTH, CONV_A_WIDTH, D_GROUP), f32) * CONV_A_WIDTH ** -0.5
    conv_a_b = 0.02 * jax.random.normal(ks[5], (DEPTH, D_GROUP), f32)
    ln_a_g = 1.0 + 0.05 * jax.random.normal(ks[6], (DEPTH, D_GROUP), f32)
    ln_a_b = 0.02 * jax.random.normal(ks[7], (DEPTH, D_GROUP), f32)
    conv_b_w = jax.random.normal(ks[8], (DEPTH, CONV_B_WIDTH, D_GROUP), f32) * CONV_B_WIDTH ** -0.5
    swa_sink = jax.random.normal(ks[9], (DEPTH, SWA_Q_HEADS), f32)
    na_rpb = 0.1 * jax.random.normal(ks[10], (DEPTH, NA_HEADS, 2 * NA_KH_MAX - 1, 2 * NA_KW - 1), f32)
    final_norm_g = 1.0 + 0.05 * jax.random.normal(ks[11], (D_MODEL,), f32)
    return {"x": x, "norm_g": norm_g, "w_in": w_in, "w_out": w_out,
            "conv_a_w": conv_a_w, "conv_a_b": conv_a_b, "ln_a_g": ln_a_g, "ln_a_b": ln_a_b,
            "conv_b_w": conv_b_w, "swa_sink": swa_sink, "na_rpb": na_rpb,
            "final_norm_g": final_norm_g}


def reference(x, norm_g, w_in, w_out, conv_a_w, conv_a_b, ln_a_g, ln_a_b,
              conv_b_w, swa_sink, na_rpb, final_norm_g):
    for l in range(DEPTH):
        x = hybrid_layer(x, norm_g[l], w_in[l], w_out[l], conv_a_w[l], conv_a_b[l],
                         ln_a_g[l], ln_a_b[l], conv_b_w[l], swa_sink[l], na_rpb[l])
    return rmsnorm(x, final_norm_g)
```

```cpp
#include <hip/hip_runtime.h>
#include <cstdio>
#include <cstdint>

#ifndef MK_N_LAUNCHES
#define MK_N_LAUNCHES 1
#endif

namespace pg8 {
#define PG8_LAS __attribute__((address_space(3)))
typedef unsigned short bf16_t;
typedef short bf16x8 __attribute__((ext_vector_type(8)));
typedef float f32x4 __attribute__((ext_vector_type(4)));
typedef unsigned u32x4 __attribute__((ext_vector_type(4)));
constexpr int BM = 256, BK = 64, HALF = 128, HTB = HALF * BK * 2  , STAGE_BYTES = 8 * HTB, NXCD = 8, WGM = 8;

__host__ __device__ __forceinline__ int lds_byte(int r, int c) { const int st = (r >> 4) * 2 + (c >> 5), rr = r & 15, cc = c & 31, ob = rr * 64 + cc * 2; return st * 1024 + (ob ^ (((ob >> 9) & 1) << 5)); }
__host__ __device__ __forceinline__ void stage_rc(int b, int& R, int& C) { const int st = b / 1024, sb = b % 1024, swz = sb ^ (((sb >> 9) & 1) << 5); R = (st >> 1) * 16 + swz / 64; C = (st & 1) * 32 + (swz % 64) / 2; }
__host__ __device__ __forceinline__ int perm32(int rho) { const int n = rho >> 4, i = rho & 15; return 8 * (i >> 2) + 4 * n + (i & 3); }

struct Unit { int pm, pn; };
struct Gemm { const bf16_t* A; const bf16_t* Bt; int M, N, K; };

struct StaticOrder {
    int nM, nN, nwg, G, c;
    __host__ __device__ void init(int M, int N, int G_, int c_) { nM = M / BM; nN = N / BM; nwg = nM * nN; G = G_; c = c_; }
    __host__ __device__ bool next(int i, Unit& u) const {
        const long L = (long)i * G + c; if (L >= nwg) return false;
        int wgid = (int)L; { const int q = nwg / NXCD, r = nwg % NXCD, xcd = wgid % NXCD, off = wgid / NXCD; wgid = (xcd < r ? xcd * (q + 1) : r * (q + 1) + (xcd - r) * q) + off; }
        const int nig = WGM * nN, gid = wgid / nig, fm = gid * WGM, gsz = (nM - fm) < WGM ? (nM - fm) : WGM;
        u.pm = fm + ((wgid % nig) % gsz); u.pn = (wgid % nig) / gsz; return true;
    }
    __device__ __forceinline__ void a_ready(const Unit&) const {}
    __device__ __forceinline__ void done(const Unit&) const {}
};

__device__ __forceinline__ unsigned cvt_pk_bf16(float lo, float hi) { unsigned r; asm volatile("v_cvt_pk_bf16_f32 %0, %1, %2" : "=v"(r) : "v"(lo), "v"(hi)); return r; }

template <class Epi, class Sched, bool ALIGN_EPI = false, bool SP2 = false>
__device__ __forceinline__ void gemm_phase(PG8_LAS unsigned char* lds, const Gemm g, const Sched& S, const Epi& E) {
    int tid = threadIdx.x; asm volatile("" : "+v"(tid));
    const int wid = __builtin_amdgcn_readfirstlane(tid >> 6), lane = tid & 63, wr = wid >> 2, wc = wid & 3, fr = lane & 15, fq = lane >> 4;
    const int K = g.K, nt = K / BK;
    unsigned voffA[2], voffB[2];
#pragma unroll
    for (int i = 0; i < 2; ++i) { int R, C; stage_rc(tid * 16 + i * 8192, R, C); const int Rb = Epi::PERM ? ((R & ~31) + perm32(R & 31)) : R;
        voffA[i] = (unsigned)(R * K + C) * 2u; voffB[i] = (unsigned)(Rb * K + C) * 2u; }
    const size_t kstep = (size_t)(BK * 2);
    const size_t hstep = (size_t)HALF * K * 2;
    const size_t tstep = 2 * hstep;
    const unsigned ldsw = (unsigned)wid * 1024u;
    const int aoff = lds_byte(wr * 64 + fr, fq * 8), boff = lds_byte(wc * 32 + fr, fq * 8);
#define PG8_SA(b, h) (((b) * 2 + (h)) * HTB)
#define PG8_SB(b, h) ((4 + (b) * 2 + (h)) * HTB)
#define PG8_STAGE(bufoff, gbase, voff) do { _Pragma("unroll") for (int _i = 0; _i < 2; ++_i) \
        __builtin_amdgcn_global_load_lds((const unsigned*)((const char*)(gbase) + (voff)[_i]), (PG8_LAS unsigned*)(lds + (bufoff) + ldsw + _i * 8192), 16, 0, 0); } while (0)
#define PG8_LDA(dst, b, h) do { _Pragma("unroll") for (int m = 0; m < 4; ++m) _Pragma("unroll") for (int k = 0; k < 2; ++k) dst[m][k] = *(const PG8_LAS bf16x8*)(lds + PG8_SA(b, h) + aoff + m * 2048 + k * 1024); } while (0)
#define PG8_LDB(dst, b, h) do { _Pragma("unroll") for (int n = 0; n < 2; ++n) _Pragma("unroll") for (int k = 0; k < 2; ++k) dst[n][k] = *(const PG8_LAS bf16x8*)(lds + PG8_SB(b, h) + boff + n * 2048 + k * 1024); } while (0)
#define PG8_MMA(ai, bj, At, Bt) do { __builtin_amdgcn_s_setprio(1); _Pragma("unroll") for (int m = 0; m < 4; ++m) _Pragma("unroll") for (int n = 0; n < 2; ++n) _Pragma("unroll") for (int k = 0; k < 2; ++k) \
        acc[ai][bj][m][n] = __builtin_amdgcn_mfma_f32_16x16x32_bf16(Bt[n][k], At[m][k], acc[ai][bj][m][n], 0, 0, 0); __builtin_amdgcn_s_setprio(0); } while (0)
#define PG8_WAIT_V(n) asm volatile("s_waitcnt vmcnt(" #n ")" ::: "memory")
#define PG8_WAIT_L(n) asm volatile("s_waitcnt lgkmcnt(" #n ")" ::: "memory")
#define PG8_BAR __builtin_amdgcn_s_barrier()
#define PG8_SCHED __builtin_amdgcn_sched_barrier(0)
    Unit cur, nxt; int ui = 0;
    if (!S.next(0, cur)) return;
    f32x4 acc[2][2][4][2];
#pragma unroll
    for (int a = 0; a < 2; ++a)
#pragma unroll
        for (int b = 0; b < 2; ++b)
#pragma unroll
            for (int m = 0; m < 4; ++m)
#pragma unroll
                for (int n = 0; n < 2; ++n) acc[a][b][m][n] = (f32x4){0.f, 0.f, 0.f, 0.f};
    bf16x8 At[4][2], B0[2][2], B1[2][2];
    const char* cA = (const char*)g.A + (size_t)cur.pm * tstep; const char* cB = (const char*)g.Bt + (size_t)cur.pn * tstep;
    S.a_ready(cur);
    if constexpr (SP2) {
        PG8_STAGE(PG8_SB(0, 0), cB, voffB); PG8_STAGE(PG8_SB(0, 1), cB + hstep, voffB); PG8_STAGE(PG8_SA(0, 0), cA, voffA); PG8_STAGE(PG8_SA(0, 1), cA + hstep, voffA);
        if (wr == 1) PG8_BAR;
        PG8_WAIT_V(2); PG8_BAR;
        PG8_STAGE(PG8_SB(1, 0), cB + kstep, voffB); PG8_STAGE(PG8_SA(1, 0), cA + kstep, voffA); PG8_STAGE(PG8_SB(1, 1), cB + hstep + kstep, voffB);
        PG8_WAIT_V(6); PG8_BAR;
    } else {
        PG8_STAGE(PG8_SB(0, 0), cB, voffB); PG8_STAGE(PG8_SA(0, 0), cA, voffA); PG8_STAGE(PG8_SB(0, 1), cB + hstep, voffB); PG8_STAGE(PG8_SA(0, 1), cA + hstep, voffA);
        if (wr == 1) PG8_BAR;
        PG8_WAIT_V(4); PG8_BAR;
        PG8_STAGE(PG8_SB(1, 0), cB + kstep, voffB); PG8_STAGE(PG8_SA(1, 0), cA + kstep, voffA); PG8_STAGE(PG8_SB(1, 1), cB + hstep + kstep, voffB);
        PG8_WAIT_V(6); PG8_BAR;
    }
    for (;;) {
        const bool has_next = S.next(ui + 1, nxt);
        const char* nA = has_next ? (const char*)g.A + (size_t)nxt.pm * tstep : cA; const char* nB = has_next ? (const char*)g.Bt + (size_t)nxt.pn * tstep : cB;
        for (int t = 0; t < nt; t += 2) {
            const bool last = (t == nt - 2);
            const char* a1 = cA + (size_t)(t + 1) * kstep;
            const char* a2 = last ? nA : cA + (size_t)(t + 2) * kstep; const char* b2 = last ? nB : cB + (size_t)(t + 2) * kstep;
            const char* a3 = a2 + kstep; const char* b3 = b2 + kstep;
            if (last && has_next) S.a_ready(nxt);
            if constexpr (SP2) {
            PG8_LDB(B0, 0, 0); PG8_LDB(B1, 0, 1); PG8_SCHED; PG8_LDA(At, 0, 0); PG8_STAGE(PG8_SA(1, 1), a1 + hstep, voffA);
            PG8_WAIT_V(8); PG8_WAIT_L(0); PG8_BAR; PG8_MMA(0, 0, At, B0); PG8_MMA(0, 1, At, B1); PG8_BAR; PG8_SCHED;
            PG8_LDA(At, 0, 1); PG8_STAGE(PG8_SB(0, 0), b2, voffB); PG8_STAGE(PG8_SB(0, 1), b2 + hstep, voffB); PG8_STAGE(PG8_SA(0, 0), a2, voffA);
            PG8_WAIT_V(8); PG8_WAIT_L(0); PG8_BAR; PG8_MMA(1, 0, At, B0); PG8_MMA(1, 1, At, B1); PG8_BAR; PG8_SCHED;
            PG8_LDB(B0, 1, 0); PG8_LDB(B1, 1, 1); PG8_SCHED; PG8_LDA(At, 1, 0); PG8_STAGE(PG8_SA(0, 1), a2 + hstep, voffA);
            PG8_WAIT_V(8); PG8_WAIT_L(0); PG8_BAR; PG8_MMA(0, 0, At, B0); PG8_MMA(0, 1, At, B1); PG8_BAR; PG8_SCHED;
            PG8_LDA(At, 1, 1); PG8_STAGE(PG8_SB(1, 0), b3, voffB); PG8_STAGE(PG8_SB(1, 1), b3 + hstep, voffB); PG8_STAGE(PG8_SA(1, 0), a3, voffA);
            PG8_WAIT_V(8); PG8_WAIT_L(0); PG8_BAR; PG8_MMA(1, 0, At, B0); PG8_MMA(1, 1, At, B1); PG8_BAR; PG8_SCHED;
            } else {
            PG8_LDB(B0, 0, 0); PG8_SCHED; PG8_LDA(At, 0, 0); PG8_STAGE(PG8_SA(1, 1), a1 + hstep, voffA);
            PG8_WAIT_L(8); PG8_BAR; PG8_WAIT_L(0); PG8_MMA(0, 0, At, B0); PG8_BAR; PG8_SCHED;
            PG8_LDB(B1, 0, 1); PG8_STAGE(PG8_SB(0, 0), b2, voffB);
            PG8_BAR; PG8_WAIT_L(0); PG8_MMA(0, 1, At, B1); PG8_BAR;
            PG8_LDA(At, 0, 1); PG8_STAGE(PG8_SA(0, 0), a2, voffA);
            PG8_BAR; PG8_WAIT_L(0); PG8_MMA(1, 0, At, B0); PG8_BAR; PG8_SCHED;
            PG8_STAGE(PG8_SB(0, 1), b2 + hstep, voffB);
            PG8_WAIT_V(6); PG8_BAR; PG8_MMA(1, 1, At, B1); PG8_BAR;
            PG8_LDB(B0, 1, 0); PG8_SCHED; PG8_LDA(At, 1, 0); PG8_STAGE(PG8_SA(0, 1), a2 + hstep, voffA);
            PG8_WAIT_L(8); PG8_BAR; PG8_WAIT_L(0); PG8_MMA(0, 0, At, B0); PG8_BAR; PG8_SCHED;
            PG8_LDB(B1, 1, 1); PG8_STAGE(PG8_SB(1, 0), b3, voffB);
            PG8_BAR; PG8_WAIT_L(0); PG8_MMA(0, 1, At, B1); PG8_BAR;
            PG8_LDA(At, 1, 1); PG8_STAGE(PG8_SA(1, 0), a3, voffA);
            PG8_BAR; PG8_WAIT_L(0); PG8_MMA(1, 0, At, B0); PG8_BAR; PG8_SCHED;
            PG8_STAGE(PG8_SB(1, 1), b3 + hstep, voffB);
            PG8_WAIT_V(6); PG8_BAR; PG8_MMA(1, 1, At, B1); PG8_BAR;
            }
        }
        if constexpr (ALIGN_EPI) { if (wr == 0) PG8_BAR; }
        if constexpr (!Epi::AFTER_DRAIN) { E(acc, cur, wr, wc, fr, fq); S.done(cur); }
        if (!has_next) break;
#pragma unroll
        for (int a = 0; a < 2; ++a)
#pragma unroll
            for (int b = 0; b < 2; ++b)
#pragma unroll
                for (int m = 0; m < 4; ++m)
#pragma unroll
                    for (int n = 0; n < 2; ++n) acc[a][b][m][n] = (f32x4){0.f, 0.f, 0.f, 0.f};
        cur = nxt; cA = nA; cB = nB; ++ui;
        if constexpr (ALIGN_EPI) { if (wr == 1) PG8_BAR; }
    }
    PG8_WAIT_V(0);
    if constexpr (!ALIGN_EPI) { if (wr == 0) PG8_BAR; }
    PG8_BAR;
    if constexpr (Epi::AFTER_DRAIN) { E.fused(acc, cur, wr, wc, fr, fq, lds, wid, lane); S.done(cur); }
#undef PG8_SA
#undef PG8_SB
#undef PG8_STAGE
#undef PG8_LDA
#undef PG8_LDB
#undef PG8_MMA
#undef PG8_WAIT_V
#undef PG8_WAIT_L
#undef PG8_BAR
#undef PG8_SCHED
}
}

constexpr int NWAVES = 8;
constexpr int N_LAUNCHES = MK_N_LAUNCHES;
constexpr int N_PHASES = 9;
constexpr int SEQ = 4096, NB = 4, M = NB * SEQ, D = 1024, NIN = 3584, DEPTH = 2;
constexpr float EPS = 1e-6f;
constexpr float LOG2E = 1.4426950408889634f;
constexpr float QSCALE = 0.125f * LOG2E;

constexpr size_t MiB = 1u << 20;
constexpr size_t WS_CTL = 0, CTL_ZERO_BYTES = 1 * MiB;
constexpr size_t WS_ROPE = 1 * MiB;
constexpr size_t WS_SSQ = 2 * MiB;
constexpr size_t WS_WIN = 4 * MiB;
constexpr size_t WS_WOUT = 18 * MiB;
constexpr size_t WS_XN = 24 * MiB;
constexpr size_t WS_Y = 56 * MiB;
constexpr size_t WS_I = 88 * MiB;
constexpr size_t WS_END = 176 * MiB;
enum { IB_H = 0, IB_AZ, IB_CX, IB_GB, IB_CQ, IB_CKV, IB_CZ, IB_DQ, IB_DK, IB_DV, IB_DZ, IB_N };
constexpr size_t IB_ELEMS = (size_t)M * 256;
constexpr int CW_TMO = 0, CW_CODE = 1;
constexpr int CW_BAR = 4096;

constexpr int RING_OFF = 0, RING_BYTES = 131072;
constexpr int LDSCTL_OFF = RING_BYTES, MISC_OFF = LDSCTL_OFF + 320;
constexpr int LDS_BYTES = 147456;

#define GAS __attribute__((address_space(1)))
#define LAS __attribute__((address_space(3)))
typedef unsigned short bf16;
typedef unsigned v4u __attribute__((ext_vector_type(4)));
typedef unsigned v2u __attribute__((ext_vector_type(2)));
typedef float f32x4 __attribute__((ext_vector_type(4)));
typedef float f32x2 __attribute__((ext_vector_type(2)));
typedef short bf16x8 __attribute__((ext_vector_type(8)));
typedef GAS unsigned gu32;
#define RLX_AGENT __ATOMIC_RELAXED, __HIP_MEMORY_SCOPE_AGENT
#define LDS_WAIT() asm volatile("s_waitcnt lgkmcnt(0)" ::: "memory")
#define VM_WAIT() asm volatile("s_waitcnt vmcnt(0)" ::: "memory")
__device__ __forceinline__ unsigned f2bf(float f) { unsigned u = __builtin_bit_cast(unsigned, f); return (u + 0x7fffu + ((u >> 16) & 1u)) >> 16; }
__device__ __forceinline__ unsigned pk2(float lo, float hi) { return f2bf(lo) | (f2bf(hi) << 16); }
__device__ __forceinline__ float bflo(unsigned w) { return __uint_as_float(w << 16); }
__device__ __forceinline__ float bfhi(unsigned w) { return __uint_as_float(w & 0xffff0000u); }
__device__ __forceinline__ float bf2f(bf16 v) { return __uint_as_float((unsigned)v << 16); }
__device__ __forceinline__ float sigmoidf_(float x) { return __builtin_amdgcn_rcpf(1.0f + __builtin_amdgcn_exp2f(-x * LOG2E)); }
__device__ __forceinline__ float siluf_(float x) { return x * sigmoidf_(x); }

#define XB_TMO      128
#define XB_XCNT(j)  (256  + 64 * (j))
#define XB_XSUB(j)  (1280 + 64 * (j))
#define XB_XGEN(j)  (2304 + 64 * (j))
#define XB_TOP      3328
#define XB_TOPGEN   3392
#define XCD_BAR_WORDS 3456
#define XB_SPIN_CAP (1u << 18)
__device__ __forceinline__ unsigned xb_ld(unsigned* p)              { return __hip_atomic_load(p, __ATOMIC_RELAXED, __HIP_MEMORY_SCOPE_AGENT); }
__device__ __forceinline__ unsigned xb_add(unsigned* p, unsigned v) { return __hip_atomic_fetch_add(p, v, __ATOMIC_RELAXED, __HIP_MEMORY_SCOPE_AGENT); }
__device__ __forceinline__ unsigned xb_xcc_id() { return (unsigned)__builtin_amdgcn_s_getreg((3 << 11) | 20) & 0xFu; }
#define XB_SPIN(cond, bar) do { unsigned _sp = 0; while (cond) { __builtin_amdgcn_s_sleep(1); \
    if ((++_sp & 255u) == 0u) { if (xb_ld(&(bar)[XB_TMO])) break; if (_sp > XB_SPIN_CAP) { atomicAdd(&(bar)[XB_TMO], 1u); break; } } } } while (0)
struct XcdBarrier { unsigned* bar; unsigned x; volatile LAS unsigned* st; };
__device__ __forceinline__ XcdBarrier xcd_barrier_post(unsigned* bar, volatile LAS unsigned* st) {
    XcdBarrier b; b.bar = bar; b.x = xb_xcc_id(); b.st = st;
    if (threadIdx.x == 0) (void)xb_add(&bar[XB_XCNT(b.x)], 1u);
    return b;
}
__device__ __forceinline__ void xcd_barrier_complete(unsigned* bar, unsigned x, unsigned& nloc, unsigned& nx) {
    const unsigned G = gridDim.x * gridDim.y * gridDim.z;
    unsigned sum, cnt, mine, sp = 0u;
    for (;;) {
        sum = 0u; cnt = 0u; mine = 0u;
#pragma unroll
        for (unsigned j = 0; j < 16; ++j) { const unsigned c = xb_ld(&bar[XB_XCNT(j)]); sum += c; cnt += (c > 0u) ? 1u : 0u; mine = (j == x) ? c : mine; }
        if (sum == G) break;
        __builtin_amdgcn_s_sleep(1);
        if ((++sp & 255u) == 0u) { if (xb_ld(&bar[XB_TMO])) break; if (sp > XB_SPIN_CAP) { atomicAdd(&bar[XB_TMO], 1u); break; } }
    }
    nloc = mine > 0u ? mine : 1u; nx = cnt > 0u ? cnt : 1u;
}
__device__ __forceinline__ void xcd_barrier(const XcdBarrier& b) {
    asm volatile("s_waitcnt vmcnt(0)" ::: "memory");
    __syncthreads();
    if (threadIdx.x == 0) {
        unsigned* bar = b.bar;
        __builtin_amdgcn_s_waitcnt(0);
        unsigned nloc = b.st[0], nx = b.st[1];
        if (nloc == 0u) { xcd_barrier_complete(bar, b.x, nloc, nx); b.st[0] = nloc; b.st[1] = nx; }
        const unsigned old = xb_add(&bar[XB_XSUB(b.x)], 1u);
        const unsigned gen = old / nloc;
        if (old + 1u == (gen + 1u) * nloc) {
            __builtin_amdgcn_fence(__ATOMIC_RELEASE, "agent");
            asm volatile("s_waitcnt vmcnt(0)" ::: "memory");
            const unsigned og = xb_add(&bar[XB_TOP], 1u);
            const unsigned tg = og / nx;
            if (og + 1u == (tg + 1u) * nx) xb_add(&bar[XB_TOPGEN], 1u);
            else XB_SPIN(xb_ld(&bar[XB_TOPGEN]) == tg, bar);
            __builtin_amdgcn_fence(__ATOMIC_ACQUIRE, "agent");
            xb_add(&bar[XB_XGEN(b.x)], 1u);
            asm volatile("s_waitcnt vmcnt(0)" ::: "memory");
        } else {
            XB_SPIN(xb_ld(&bar[XB_XGEN(b.x)]) == gen, bar);
            __builtin_amdgcn_fence(__ATOMIC_ACQUIRE, "agent");
            asm volatile("s_waitcnt vmcnt(0)" ::: "memory");
        }
    }
    __syncthreads();
}

struct Frame {
    LAS unsigned char* lds;
    volatile LAS unsigned* MISC;
    gu32* ctl;
    int tid, lane, wave;
    int vcu, G;
    const float* x; float* out;
    const float *norm_g, *w_in, *w_out, *conv_a_w, *conv_a_b, *ln_a_g, *ln_a_b, *conv_b_w, *swa_sink, *na_rpb, *final_g;
    bf16 *Win_t, *Wout_t, *XN, *Y, *IB;
    f32x2* rope; float* ssqp;
};

__device__ __forceinline__ int opaque_tid() { int t = threadIdx.x; asm volatile("" : "+v"(t)); return t; }
__device__ __forceinline__ float wave_sum(float v) {
#pragma unroll
    for (int o = 1; o < 64; o <<= 1) v += __shfl_xor(v, o);
    return v;
}
__device__ __forceinline__ float wave_max(float v) {
#pragma unroll
    for (int o = 1; o < 64; o <<= 1) v = fmaxf(v, __shfl_xor(v, o));
    return v;
}

__host__ __device__ __forceinline__ int sigma32(int nb  ) {
    const int pn = nb >> 3, g = nb & 7, half = g >> 2, jj = (g & 3) * 32;
    switch (pn) {
        case 0: return (half ? 256 : 0) + jj;
        case 1: return (half ? 256 : 0) + 128 + jj;
        case 2: return (half ? 1280 : 1024) + jj;
        case 3: return (half ? 1280 : 1024) + 128 + jj;
        case 4: return (half ? 1536 : 768) + jj;
        case 5: return (half ? 1536 : 768) + 128 + jj;
        case 6: return 512 + g * 32;
        case 7: return 1792 + 64 * (g & 3) + (half ? 32 : 0);
        case 8: return (g & 3) < 2 ? 2048 + 64 * (g & 3) + (half ? 32 : 0)
                                   : 2176 + 64 * half + 32 * ((g & 3) - 2);
        case 9: return 2304 + g * 32;
        case 10: return 2560 + g * 32;
        case 11: return 2816 + g * 32;
        case 12: return 3072 + g * 32;
        default: return 3328 + g * 32;
    }
}

__device__ __forceinline__ void p0_transpose_item(const float* W, int K, int N, bf16* WT, int k0, int nrow0, int src_col0, const float* gain, LAS float* scr, int lane) {
#pragma unroll 8
    for (int i = 0; i < 32; ++i) { const int kk = 2 * i + (lane >> 5); float w = W[(size_t)(k0 + kk) * N + src_col0 + (lane & 31)]; if (gain) w *= gain[k0 + kk]; scr[kk * 33 + (lane & 31)] = w; }
    LDS_WAIT(); asm volatile("" ::: "memory");
    const int c = lane & 7;
#pragma unroll
    for (int j = 0; j < 4; ++j) { const int n = (lane >> 3) + 8 * j; const LAS float* s = scr + (8 * c) * 33 + n;
        v4u o; o.x = pk2(s[0 * 33], s[1 * 33]); o.y = pk2(s[2 * 33], s[3 * 33]); o.z = pk2(s[4 * 33], s[5 * 33]); o.w = pk2(s[6 * 33], s[7 * 33]);
        *(GAS v4u*)(WT + (size_t)(nrow0 + n) * K + k0 + 8 * c) = o; }
    LDS_WAIT(); asm volatile("" ::: "memory");
}
__device__ __forceinline__ void row_to_bf16_ssq(int lane, const float* xrow, bf16* orow, float* ssqp, int m) {
    const GAS f32x4* xr = (const GAS f32x4*)xrow + lane;
    f32x4 v[4]; float s = 0.f;
#pragma unroll
    for (int j = 0; j < 4; ++j) { v[j] = xr[64 * j]; s += (v[j].x * v[j].x + v[j].y * v[j].y) + (v[j].z * v[j].z + v[j].w * v[j].w); }
    s = wave_sum(s);
    if (lane < 4) ssqp[(size_t)lane * M + m] = lane == 0 ? s : 0.f;
    GAS unsigned long long* o8 = (GAS unsigned long long*)orow + lane;
#pragma unroll
    for (int j = 0; j < 4; ++j) o8[64 * j] = (unsigned long long)pk2(v[j].x, v[j].y) | ((unsigned long long)pk2(v[j].z, v[j].w) << 32);
}
__device__ __forceinline__ void rms_row_final(int lane, const float* xrow, float* orow, const float* g, const float* ssqp, int m) {
    const GAS f32x4* xr = (const GAS f32x4*)xrow + lane;
    f32x4 v[4];
#pragma unroll
    for (int j = 0; j < 4; ++j) v[j] = xr[64 * j];
    const float rstd = 1.0f / sqrtf(((ssqp[m] + ssqp[M + m]) + (ssqp[2 * M + m] + ssqp[3 * M + m])) * (1.f / D) + EPS);
    GAS f32x4* o = (GAS f32x4*)orow + lane;
#pragma unroll
    for (int j = 0; j < 4; ++j) { const f32x4 gg = ((const GAS f32x4*)g)[lane + 64 * j]; o[64 * j] = v[j] * rstd * gg; }
}

__device__ __forceinline__ void p0_prologue(Frame& F) {
    const int tid_ = opaque_tid(), lane_ = tid_ & 63, wave_ = __builtin_amdgcn_readfirstlane(tid_ >> 6);
    LAS float* scr = (LAS float*)(F.lds + RING_OFF + wave_ * 16384);
    const int gw = F.vcu * NWAVES + wave_, NGW = F.G * NWAVES;
    constexpr int I_IN = (D / 64) * (NIN / 32), I_OUT = (D / 64) * (D / 32);
    constexpr int NITEMS = DEPTH * (I_IN + I_OUT);
    for (int it = gw; it < NITEMS; it += NGW) {
        int r = it; const int l = r / (I_IN + I_OUT); r -= l * (I_IN + I_OUT);
        if (r < I_IN) { const int nblk = NIN / 32, kb = r / nblk, nb = r % nblk;
            p0_transpose_item(F.w_in + (size_t)l * D * NIN, D, NIN, F.Win_t + (size_t)l * NIN * D, 64 * kb, 32 * nb, sigma32(nb), F.norm_g + l * D, scr, lane_); }
        else { r -= I_IN; const int nblk = D / 32, kb = r / nblk, nb = r % nblk;
            p0_transpose_item(F.w_out + (size_t)l * D * D, D, D, F.Wout_t + (size_t)l * D * D, 64 * kb, 32 * nb, 32 * nb, nullptr, scr, lane_); }
    }
    for (int i = gw * 64 + lane_; i < SEQ * 32; i += NGW * 64) {
        const int pos = i >> 5, d = i & 31;
        const float inv_freq = exp2f(-(float)d * (13.287712379549449f / 32.0f));
        const float ang = (float)pos * inv_freq;
        const double a = (double)ang; const double k = rint(a * 0.15915494309189535); const double rr = a - k * 6.283185307179586476925;
        F.rope[i] = (f32x2){(float)cos(rr), (float)sin(rr)};
    }
    for (int m = gw; m < M; m += NGW) row_to_bf16_ssq(lane_, F.x + (size_t)m * D, F.XN + (size_t)m * D, F.ssqp, m);
}

struct EpiInProj {
    static constexpr bool PERM = true, AFTER_DRAIN = false;
    bf16* IB; const f32x2* rope; const float* ssqp;
    __device__ __forceinline__ static v4u pack8(const f32x4 a, const f32x4 b) { v4u w; w.x = pg8::cvt_pk_bf16(a[0], a[1]); w.y = pg8::cvt_pk_bf16(a[2], a[3]); w.z = pg8::cvt_pk_bf16(b[0], b[1]); w.w = pg8::cvt_pk_bf16(b[2], b[3]); return w; }
    __device__ __forceinline__ void operator()(const f32x4 (&acc)[2][2][4][2], const pg8::Unit& u, int wr, int wc, int fr, int fq) const {
        const int pn = u.pn, row0 = u.pm * 256 + wr * 64 + fr, cl = wc * 32 + 8 * fq;
        float rs[2][4];
#pragma unroll
        for (int ai = 0; ai < 2; ++ai)
#pragma unroll
            for (int m = 0; m < 4; ++m) { const float* sp = ssqp + row0 + ai * 128 + m * 16; rs[ai][m] = 1.0f / sqrtf(((sp[0] + sp[M]) + (sp[2 * M] + sp[3 * M])) * (1.f / D) + EPS); }
        if (pn < 6) {
            bf16* O = IB + (size_t)(pn < 2 ? IB_H : pn < 4 ? IB_CX : IB_GB) * IB_ELEMS + 128 * (pn & 1) + cl;
#pragma unroll
            for (int ai = 0; ai < 2; ++ai)
#pragma unroll
                for (int m = 0; m < 4; ++m) {
                    f32x4 o[2];
#pragma unroll
                    for (int n = 0; n < 2; ++n) { const f32x4 a = acc[ai][0][m][n] * rs[ai][m], b = acc[ai][1][m][n] * rs[ai][m];
#pragma unroll
                        for (int i = 0; i < 4; ++i) o[n][i] = pn < 2 ? a[i] * sigmoidf_(b[i]) : pn < 4 ? a[i] * b[i] : a[i] * siluf_(b[i]); }
                    *(v4u*)(O + (size_t)(row0 + ai * 128 + m * 16) * 256) = pack8(o[0], o[1]);
                }
        } else if (pn == 7) {
            bf16* O = IB + (size_t)IB_CQ * IB_ELEMS + 64 * wc + 8 * fq;
#pragma unroll
            for (int ai = 0; ai < 2; ++ai)
#pragma unroll
                for (int m = 0; m < 4; ++m) { const int row = row0 + ai * 128 + m * 16; const f32x4* rp = (const f32x4*)(rope + (size_t)(row & (SEQ - 1)) * 32 + 8 * fq);
                    f32x4 o1[2], o2[2];
#pragma unroll
                    for (int n = 0; n < 2; ++n) { const f32x4 cs0 = rp[2 * n], cs1 = rp[2 * n + 1]; const f32x4 x1 = acc[ai][0][m][n] * (QSCALE * rs[ai][m]), x2 = acc[ai][1][m][n] * (QSCALE * rs[ai][m]);
                        o1[n][0] = x1[0] * cs0[0] - x2[0] * cs0[1]; o2[n][0] = x2[0] * cs0[0] + x1[0] * cs0[1];
                        o1[n][1] = x1[1] * cs0[2] - x2[1] * cs0[3]; o2[n][1] = x2[1] * cs0[2] + x1[1] * cs0[3];
                        o1[n][2] = x1[2] * cs1[0] - x2[2] * cs1[1]; o2[n][2] = x2[2] * cs1[0] + x1[2] * cs1[1];
                        o1[n][3] = x1[3] * cs1[2] - x2[3] * cs1[3]; o2[n][3] = x2[3] * cs1[2] + x1[3] * cs1[3]; }
                    *(v4u*)(O + (size_t)row * 256) = pack8(o1[0], o1[1]); *(v4u*)(O + (size_t)row * 256 + 32) = pack8(o2[0], o2[1]);
                    asm volatile("" ::: "memory"); }
        } else if (pn == 8) {
            if (wc < 2) {
                bf16* O = IB + (size_t)IB_CKV * IB_ELEMS + 64 * wc + 8 * fq;
#pragma unroll
                for (int ai = 0; ai < 2; ++ai)
#pragma unroll
                    for (int m = 0; m < 4; ++m) { const int row = row0 + ai * 128 + m * 16; const f32x4* rp = (const f32x4*)(rope + (size_t)(row & (SEQ - 1)) * 32 + 8 * fq);
                        f32x4 o1[2], o2[2];
#pragma unroll
                        for (int n = 0; n < 2; ++n) { const f32x4 cs0 = rp[2 * n], cs1 = rp[2 * n + 1]; const f32x4 x1 = acc[ai][0][m][n] * rs[ai][m], x2 = acc[ai][1][m][n] * rs[ai][m];
                            o1[n][0] = x1[0] * cs0[0] - x2[0] * cs0[1]; o2[n][0] = x2[0] * cs0[0] + x1[0] * cs0[1];
                            o1[n][1] = x1[1] * cs0[2] - x2[1] * cs0[3]; o2[n][1] = x2[1] * cs0[2] + x1[1] * cs0[3];
                            o1[n][2] = x1[2] * cs1[0] - x2[2] * cs1[1]; o2[n][2] = x2[2] * cs1[0] + x1[2] * cs1[1];
                            o1[n][3] = x1[3] * cs1[2] - x2[3] * cs1[3]; o2[n][3] = x2[3] * cs1[2] + x1[3] * cs1[3]; }
                        *(v4u*)(O + (size_t)row * 256) = pack8(o1[0], o1[1]); *(v4u*)(O + (size_t)row * 256 + 32) = pack8(o2[0], o2[1]);
                        asm volatile("" ::: "memory"); }
            } else {
                bf16* O = IB + (size_t)IB_CKV * IB_ELEMS + 128 + 32 * (wc - 2) + 8 * fq;
#pragma unroll
                for (int ai = 0; ai < 2; ++ai)
#pragma unroll
                    for (int m = 0; m < 4; ++m) { const int row = row0 + ai * 128 + m * 16;
#pragma unroll
                        for (int bj = 0; bj < 2; ++bj) *(v4u*)(O + (size_t)row * 256 + 64 * bj) = pack8(acc[ai][bj][m][0] * rs[ai][m], acc[ai][bj][m][1] * rs[ai][m]); }
            }
        } else {
            const int ib = pn == 6 ? IB_AZ : pn == 9 ? IB_CZ : pn == 10 ? IB_DQ : pn == 11 ? IB_DK : pn == 12 ? IB_DV : IB_DZ;
            const int mode = (pn == 6 || pn == 9 || pn == 13) ? 1 : (pn == 10 ? 2 : 0);
            bf16* O = IB + (size_t)ib * IB_ELEMS + cl;
#pragma unroll
            for (int ai = 0; ai < 2; ++ai)
#pragma unroll
                for (int m = 0; m < 4; ++m) { const int row = row0 + ai * 128 + m * 16;
#pragma unroll
                    for (int bj = 0; bj < 2; ++bj) { f32x4 v[2];
#pragma unroll
                        for (int n = 0; n < 2; ++n) { v[n] = acc[ai][bj][m][n] * rs[ai][m];
                            if (mode == 1) {
#pragma unroll
                                for (int i = 0; i < 4; ++i) v[n][i] = siluf_(v[n][i]); }
                            else if (mode == 2) v[n] = v[n] * QSCALE; }
                        *(v4u*)(O + (size_t)row * 256 + 128 * bj) = pack8(v[0], v[1]); } }
        }
    }
};
struct EpiOutProj {
    static constexpr bool PERM = true, AFTER_DRAIN = true;
    const float* base; float* out; bf16* xn; float* ssqp;
    __device__ __forceinline__ void fused(f32x4 (&acc)[2][2][4][2], const pg8::Unit& u, int wr, int wc, int fr, int fq, LAS unsigned char* lds, int wid, int lane) const {
        const int row0 = u.pm * 256 + wr * 64 + fr, col0 = u.pn * 256 + wc * 32 + 8 * fq;
        LAS float* P = (LAS float*)lds;
#pragma unroll
        for (int ai = 0; ai < 2; ++ai)
#pragma unroll
            for (int m = 0; m < 4; ++m) { const size_t off = (size_t)(row0 + ai * 128 + m * 16) * D + col0; float q = 0.f;
#pragma unroll
                for (int bj = 0; bj < 2; ++bj) { const f32x4 v0 = *(const f32x4*)(base + off + bj * 128) + acc[ai][bj][m][0], v1 = *(const f32x4*)(base + off + bj * 128 + 4) + acc[ai][bj][m][1];
                    *(f32x4*)(out + off + bj * 128) = v0; *(f32x4*)(out + off + bj * 128 + 4) = v1;
                    q += ((v0[0] * v0[0] + v0[1] * v0[1]) + (v0[2] * v0[2] + v0[3] * v0[3])) + ((v1[0] * v1[0] + v1[1] * v1[1]) + (v1[2] * v1[2] + v1[3] * v1[3]));
                    if (xn) *(v4u*)(xn + off + bj * 128) = EpiInProj::pack8(v0, v1); }
                q += __shfl_xor(q, 16); q += __shfl_xor(q, 32);
                if (fq == 0) P[(ai * 128 + wr * 64 + m * 16 + fr) * 4 + wc] = q;
                if (m & 1) asm volatile("" ::: "memory"); }
        asm volatile("s_waitcnt lgkmcnt(0)" ::: "memory"); __builtin_amdgcn_s_barrier(); asm volatile("" ::: "memory");
        const int t = wid * 64 + lane;
        if (t < 256) { const f32x4 p = *(const LAS f32x4*)(P + 4 * t); ssqp[(size_t)u.pn * M + u.pm * 256 + t] = (p[0] + p[1]) + (p[2] + p[3]); }
    }
};

__device__ __forceinline__ void mixer_a(Frame& F, int layer) {
    LAS unsigned char* lds = F.lds;
    const bf16* H = F.IB + (size_t)IB_H * IB_ELEMS; const bf16* AZ = F.IB + (size_t)IB_AZ * IB_ELEMS;
    const float* cw = F.conv_a_w + layer * 31 * 256; const float* cb = F.conv_a_b + layer * 256; const float* lg = F.ln_a_g + layer * 256; const float* lb = F.ln_a_b + layer * 256;
    const int tid_ = opaque_tid(), lane_ = tid_ & 63, wave_ = __builtin_amdgcn_readfirstlane(tid_ >> 6);
    const int cp = tid_ & 127, tq = tid_ >> 7;
    for (int u = F.vcu; u < M / 64; u += F.G) {
        const int t0 = u * 64, s0 = t0 & (SEQ - 1), bbase = t0 - s0;
        for (int c = tid_; c < 94 * 32; c += 512) { const int i = c >> 5, ch = c & 31, s = s0 - 15 + i; v4u v = (v4u){0u, 0u, 0u, 0u};
            if (s >= 0 && s < SEQ) v = *(const GAS v4u*)(H + (size_t)(bbase + s) * 256 + ch * 8);
            *(LAS v4u*)(lds + i * 512 + ch * 16) = v; }
        __syncthreads();
        {
            float w0[31], w1[31];
#pragma unroll
            for (int j = 0; j < 31; ++j) { const f32x2 w = *(const GAS f32x2*)(cw + j * 256 + 2 * cp); w0[j] = w.x; w1[j] = w.y; }
            const f32x2 bb = *(const GAS f32x2*)(cb + 2 * cp);
            float a0[16], a1[16];
#pragma unroll
            for (int o = 0; o < 16; ++o) { a0[o] = bb.x; a1[o] = bb.y; }
#pragma unroll
            for (int i = 0; i < 46; ++i) { const unsigned hv = *(const LAS unsigned*)(lds + (tq * 16 + i) * 512 + cp * 4); const float h0 = bflo(hv), h1 = bfhi(hv);
#pragma unroll
                for (int o = 0; o < 16; ++o) { const int j = i - o; if (j >= 0 && j <= 30) { a0[o] += w0[j] * h0; a1[o] += w1[j] * h1; } } }
#pragma unroll
            for (int o = 0; o < 16; ++o) *(LAS f32x2*)(lds + 49152 + ((tq * 16 + o) * 256 + 2 * cp) * 4) = (f32x2){a0[o], a1[o]};
        }
        __syncthreads();
        {
            const f32x4 g4 = *(const GAS f32x4*)(lg + 4 * lane_), b4 = *(const GAS f32x4*)(lb + 4 * lane_);
#pragma unroll 2
            for (int k = 0; k < 8; ++k) { const int tok = 8 * wave_ + k; const f32x4 xv = *(const LAS f32x4*)(lds + 49152 + (tok * 256 + 4 * lane_) * 4);
                const float mean = wave_sum((xv.x + xv.y) + (xv.z + xv.w)) * (1.f / 256.f); const f32x4 d = xv - mean;
                const float var = wave_sum((d.x * d.x + d.y * d.y) + (d.z * d.z + d.w * d.w)) * (1.f / 256.f); const float rstd = 1.0f / sqrtf(var + EPS);
                const f32x4 y = d * rstd * g4 + b4;
                const v2u az = *(const GAS v2u*)(AZ + (size_t)(t0 + tok) * 256 + 4 * lane_);
                v2u o; o.x = pk2(siluf_(y.x) * bflo(az.x), siluf_(y.y) * bfhi(az.x)); o.y = pk2(siluf_(y.z) * bflo(az.y), siluf_(y.w) * bfhi(az.y));
                *(GAS v2u*)(F.Y + (size_t)(t0 + tok) * D + 4 * lane_) = o; }
        }
        __syncthreads();
    }
}
__device__ __forceinline__ void mixer_b(Frame& F, int layer) {
    const bf16* CX = F.IB + (size_t)IB_CX * IB_ELEMS; const bf16* GB = F.IB + (size_t)IB_GB * IB_ELEMS; const float* w = F.conv_b_w + layer * 3 * 256;
    const int tid_ = opaque_tid();
    for (int it = F.vcu * 512 + tid_; it < M * 32; it += F.G * 512) { const int t = it >> 5, ch = (it & 31) * 8, s = t & (SEQ - 1);
        const v4u z = (v4u){0u, 0u, 0u, 0u};
        const v4u xm = s > 0 ? *(const GAS v4u*)(CX + (size_t)(t - 1) * 256 + ch) : z, x0 = *(const GAS v4u*)(CX + (size_t)t * 256 + ch), xp = s < SEQ - 1 ? *(const GAS v4u*)(CX + (size_t)(t + 1) * 256 + ch) : z;
        const v4u gb = *(const GAS v4u*)(GB + (size_t)t * 256 + ch);
        v4u o;
#pragma unroll
        for (int q = 0; q < 4; ++q) { const int c0 = ch + 2 * q;
            const float r0 = w[c0] * bflo(xm[q]) + w[256 + c0] * bflo(x0[q]) + w[512 + c0] * bflo(xp[q]);
            const float r1 = w[c0 + 1] * bfhi(xm[q]) + w[256 + c0 + 1] * bfhi(x0[q]) + w[512 + c0 + 1] * bfhi(xp[q]);
            o[q] = pk2(bflo(gb[q]) * r0, bfhi(gb[q]) * r1); }
        *(GAS v4u*)(F.Y + (size_t)t * D + 256 + ch) = o; }
}
typedef short v4i16_t __attribute__((ext_vector_type(4)));
constexpr int ATT_PITCH = 144;
struct AttnState { float m, l; f32x4 o[4]; };
__device__ __forceinline__ bf16x8 vtr2(const LAS unsigned char* p) {
    const v4i16_t lo = __builtin_amdgcn_ds_read_tr16_b64_v4i16((LAS v4i16_t*)p), hi = __builtin_amdgcn_ds_read_tr16_b64_v4i16((LAS v4i16_t*)(p + 16 * ATT_PITCH));
    return (bf16x8){lo[0], lo[1], lo[2], lo[3], hi[0], hi[1], hi[2], hi[3]};
}
__device__ __forceinline__ void attn_step(AttnState& st, f32x4 s0, f32x4 s1, const bf16x8 (&vf)[4]) {
    float mx = fmaxf(fmaxf(fmaxf(s0[0], s0[1]), fmaxf(s0[2], s0[3])), fmaxf(fmaxf(s1[0], s1[1]), fmaxf(s1[2], s1[3])));
    mx = fmaxf(mx, __shfl_xor(mx, 16)); mx = fmaxf(mx, __shfl_xor(mx, 32));
    if (__any(mx > st.m)) { const float mn = fmaxf(st.m, mx), a = __builtin_amdgcn_exp2f(st.m - mn); st.l *= a;
#pragma unroll
        for (int dt = 0; dt < 4; ++dt) st.o[dt] = st.o[dt] * a;
        st.m = mn; }
    f32x4 p0, p1;
#pragma unroll
    for (int r = 0; r < 4; ++r) { p0[r] = __builtin_amdgcn_exp2f(s0[r] - st.m); p1[r] = __builtin_amdgcn_exp2f(s1[r] - st.m); }
    st.l += ((p0[0] + p0[1]) + (p0[2] + p0[3])) + ((p1[0] + p1[1]) + (p1[2] + p1[3]));
    v4u pw; pw.x = pg8::cvt_pk_bf16(p0[0], p0[1]); pw.y = pg8::cvt_pk_bf16(p0[2], p0[3]); pw.z = pg8::cvt_pk_bf16(p1[0], p1[1]); pw.w = pg8::cvt_pk_bf16(p1[2], p1[3]);
    const bf16x8 pf = __builtin_bit_cast(bf16x8, pw);
#pragma unroll
    for (int dt = 0; dt < 4; ++dt) st.o[dt] = __builtin_amdgcn_mfma_f32_16x16x32_bf16(vf[dt], pf, st.o[dt], 0, 0, 0);
}
__device__ __forceinline__ void attn_finish(const AttnState& st, const bf16* gate_row, bf16* out_row, int g) {
    float l = st.l; l += __shfl_xor(l, 16); l += __shfl_xor(l, 32); const float inv = 1.0f / l;
#pragma unroll
    for (int dt = 0; dt < 4; ++dt) { const v2u gz = *(const GAS v2u*)(gate_row + 16 * dt + 4 * g); const f32x4 o = st.o[dt] * inv;
        v2u w; w.x = pk2(o[0] * bflo(gz.x), o[1] * bfhi(gz.x)); w.y = pk2(o[2] * bflo(gz.y), o[3] * bfhi(gz.y));
        *(GAS v2u*)(out_row + 16 * dt + 4 * g) = w; }
}
__device__ __forceinline__ void mixer_c(Frame& F, int layer) {
    const bf16* CQ = F.IB + (size_t)IB_CQ * IB_ELEMS; const bf16* CKV = F.IB + (size_t)IB_CKV * IB_ELEMS; const bf16* CZ = F.IB + (size_t)IB_CZ * IB_ELEMS;
    const int tid_ = opaque_tid(), lane = tid_ & 63, wave_ = __builtin_amdgcn_readfirstlane(tid_ >> 6), g = lane >> 4, li = lane & 15;
    LAS unsigned char* Kl = F.lds; LAS unsigned char* Vl = F.lds + 384 * ATT_PITCH;
    for (int u = F.vcu; u < NB * 32 * 2; u += F.G) {
        const int kvh = u & 1, n = (u >> 1) & 31, b = u >> 6;
        const int tq0 = b * SEQ + n * 128, tk0 = tq0 - 128, kk_lo = n == 0 ? 128 : 0, kk_hi = n == 31 ? 255 : 383;
        __syncthreads();
#pragma unroll
        for (int it = 0; it < 6; ++it) { const int c = tid_ + 512 * it, row = c >> 3, ch = c & 7;
            if (row >= kk_lo && row <= kk_hi) { const bf16* src = CKV + (size_t)(tk0 + row) * 256 + 64 * kvh + 8 * ch;
                const v4u kv = *(const GAS v4u*)src, vv = *(const GAS v4u*)(src + 128);
                *(LAS v4u*)(Kl + row * ATT_PITCH + ch * 16) = kv; *(LAS v4u*)(Vl + row * ATT_PITCH + ch * 16) = vv; } }
        __syncthreads();
        const int hq = 2 * kvh + (wave_ >> 2), wq = wave_ & 3;
        bf16x8 qf[2][2];
#pragma unroll
        for (int qt = 0; qt < 2; ++qt)
#pragma unroll
            for (int ks = 0; ks < 2; ++ks) qf[qt][ks] = *(const GAS bf16x8*)(CQ + (size_t)(tq0 + 32 * wq + 16 * qt + li) * 256 + 64 * hq + 32 * ks + 8 * g);
        const float sink = F.swa_sink[layer * 4 + hq] * LOG2E;
        AttnState st[2];
#pragma unroll
        for (int qt = 0; qt < 2; ++qt) { st[qt].m = sink; st[qt].l = g == 0 ? 1.0f : 0.0f;
#pragma unroll
            for (int dt = 0; dt < 4; ++dt) st[qt].o[dt] = (f32x4){0.f, 0.f, 0.f, 0.f}; }
#pragma unroll 1
        for (int s = 0; s < 9; ++s) { const int kb = 32 * wq + 32 * s; if (kb < kk_lo || kb > kk_hi) continue;
            bf16x8 kf[2][2], vf[4];
#pragma unroll
            for (int kt = 0; kt < 2; ++kt)
#pragma unroll
                for (int ks = 0; ks < 2; ++ks) kf[kt][ks] = *(const LAS bf16x8*)(Kl + (kb + 16 * kt + li) * ATT_PITCH + (32 * ks + 8 * g) * 2);
#pragma unroll
            for (int dt = 0; dt < 4; ++dt) vf[dt] = vtr2(Vl + (kb + 4 * g + (li >> 2)) * ATT_PITCH + (16 * dt + 4 * (li & 3)) * 2);
#pragma unroll
            for (int qt = 0; qt < 2; ++qt) { const f32x4 z = (f32x4){0.f, 0.f, 0.f, 0.f};
                f32x4 s0 = __builtin_amdgcn_mfma_f32_16x16x32_bf16(kf[0][0], qf[qt][0], z, 0, 0, 0); s0 = __builtin_amdgcn_mfma_f32_16x16x32_bf16(kf[0][1], qf[qt][1], s0, 0, 0, 0);
                f32x4 s1 = __builtin_amdgcn_mfma_f32_16x16x32_bf16(kf[1][0], qf[qt][0], z, 0, 0, 0); s1 = __builtin_amdgcn_mfma_f32_16x16x32_bf16(kf[1][1], qf[qt][1], s1, 0, 0, 0);
                if (s == 0 || s == 8) { const int qrel = 16 * qt + li;
#pragma unroll
                    for (int r = 0; r < 4; ++r) { const int k0 = 4 * g + r, k1 = 16 + 4 * g + r;
                        const bool v0 = s == 0 ? k0 >= qrel : k0 <= qrel, v1 = s == 0 ? k1 >= qrel : k1 <= qrel;
                        s0[r] = v0 ? s0[r] : -INFINITY; s1[r] = v1 ? s1[r] : -INFINITY; } }
                attn_step(st[qt], s0, s1, vf); }
        }
#pragma unroll
        for (int qt = 0; qt < 2; ++qt) { const size_t tok = (size_t)(tq0 + 32 * wq + 16 * qt + li);
            attn_finish(st[qt], CZ + tok * 256 + 64 * hq, F.Y + tok * D + 512 + 64 * hq, g); }
    }
}
constexpr int NA_BIAS_OFF = 9 * 64 * ATT_PITCH;
__device__ __forceinline__ void mixer_d(Frame& F, int layer) {
    const bf16* DQ = F.IB + (size_t)IB_DQ * IB_ELEMS; const bf16* DK = F.IB + (size_t)IB_DK * IB_ELEMS; const bf16* DV = F.IB + (size_t)IB_DV * IB_ELEMS; const bf16* DZ = F.IB + (size_t)IB_DZ * IB_ELEMS;
    const int tid_ = opaque_tid(), lane = tid_ & 63, wave_ = __builtin_amdgcn_readfirstlane(tid_ >> 6), g = lane >> 4, li = lane & 15;
    LAS unsigned char* Vl = F.lds; LAS float* bias = (LAS float*)(F.lds + NA_BIAS_OFF);
    for (int u = F.vcu; u < NB * 4 * 32; u += F.G) {
        const int rp = u & 31, h = (u >> 5) & 3, b = u >> 7, ra = 2 * rp;
        const int r0a = ra - 4 < 0 ? 0 : (ra - 4 > 56 ? 56 : ra - 4), r0b = ra - 3 < 0 ? 0 : (ra - 3 > 56 ? 56 : ra - 3), nrows = r0b + 8 - r0a;
        const size_t tb = (size_t)b * SEQ;
        __syncthreads();
        for (int c = tid_; c < nrows * 64 * 8; c += 512) { const int row = c >> 3, ch = c & 7;
            *(LAS v4u*)(Vl + row * ATT_PITCH + ch * 16) = *(const GAS v4u*)(DV + (tb + r0a * 64 + row) * 256 + 64 * h + 8 * ch); }
        for (int c = tid_; c < 544; c += 512) { const int e = c - 32; bias[c] = (e >= 0 && e < 465) ? F.na_rpb[(size_t)(layer * 4 + h) * 465 + e] * LOG2E : 0.f; }
        __syncthreads();
        const int rr = wave_ >> 2, qg = wave_ & 3, r = ra + rr, r0 = rr ? r0b : r0a, wc0 = qg == 0 ? 0 : qg == 1 ? 8 : qg == 2 ? 24 : 32;
        const int c = 16 * qg + li, c0 = c - 8 < 0 ? 0 : (c - 8 > 48 ? 48 : c - 8), lo = c0 - wc0;
        const size_t tokq = tb + r * 64 + c;
        bf16x8 qf[2];
#pragma unroll
        for (int ks = 0; ks < 2; ++ks) qf[ks] = *(const GAS bf16x8*)(DQ + tokq * 256 + 64 * h + 32 * ks + 8 * g);
        AttnState st; st.m = -1e30f; st.l = 0.f;
#pragma unroll
        for (int dt = 0; dt < 4; ++dt) st.o[dt] = (f32x4){0.f, 0.f, 0.f, 0.f};
        const bf16* kbase = DK + (tb + wc0 + li) * 256 + 64 * h + 8 * g;
        bf16x8 kf[2][2];
#pragma unroll
        for (int kt = 0; kt < 2; ++kt)
#pragma unroll
            for (int ks = 0; ks < 2; ++ks) kf[kt][ks] = *(const GAS bf16x8*)(kbase + (size_t)(r0 * 64 + 16 * kt) * 256 + 32 * ks);
#pragma unroll 1
        for (int ki = 0; ki < 8; ++ki) { const int kr = r0 + ki, krn = ki < 7 ? kr + 1 : kr;
            bf16x8 kn[2][2], vf[4];
#pragma unroll
            for (int kt = 0; kt < 2; ++kt)
#pragma unroll
                for (int ks = 0; ks < 2; ++ks) kn[kt][ks] = *(const GAS bf16x8*)(kbase + (size_t)(krn * 64 + 16 * kt) * 256 + 32 * ks);
#pragma unroll
            for (int dt = 0; dt < 4; ++dt) vf[dt] = vtr2(Vl + ((kr - r0a) * 64 + wc0 + 4 * g + (li >> 2)) * ATT_PITCH + (16 * dt + 4 * (li & 3)) * 2);
            const f32x4 z = (f32x4){0.f, 0.f, 0.f, 0.f};
            f32x4 s0 = __builtin_amdgcn_mfma_f32_16x16x32_bf16(kf[0][0], qf[0], z, 0, 0, 0); s0 = __builtin_amdgcn_mfma_f32_16x16x32_bf16(kf[0][1], qf[1], s0, 0, 0, 0);
            f32x4 s1 = __builtin_amdgcn_mfma_f32_16x16x32_bf16(kf[1][0], qf[0], z, 0, 0, 0); s1 = __builtin_amdgcn_mfma_f32_16x16x32_bf16(kf[1][1], qf[1], s1, 0, 0, 0);
            const LAS float* brow = bias + 32 + (kr - r + 7) * 31 + (wc0 - c + 15);
#pragma unroll
            for (int q = 0; q < 4; ++q) { const int k0 = 4 * g + q, k1 = 16 + 4 * g + q;
                const float b0 = brow[k0], b1 = brow[k1];
                s0[q] = (k0 >= lo && k0 <= lo + 15) ? s0[q] + b0 : -INFINITY; s1[q] = (k1 >= lo && k1 <= lo + 15) ? s1[q] + b1 : -INFINITY; }
            attn_step(st, s0, s1, vf);
#pragma unroll
            for (int kt = 0; kt < 2; ++kt)
#pragma unroll
                for (int ks = 0; ks < 2; ++ks) kf[kt][ks] = kn[kt][ks];
        }
        attn_finish(st, DZ + tokq * 256 + 64 * h, F.Y + tokq * D + 768 + 64 * h, g);
    }
}

struct Args { const float* in[12]; float* out; unsigned char* ws; int ph_lo, ph_hi, li, pad; };
__global__ void __launch_bounds__(NWAVES * 64, 2) hymba_fwd(Args args) {
    extern __shared__ __attribute__((aligned(16))) unsigned char lds[];
    Frame F;
    F.lds = (LAS unsigned char*)lds;
    F.MISC = (volatile LAS unsigned*)(F.lds + MISC_OFF);
    F.tid = threadIdx.x; F.lane = F.tid & 63; F.wave = __builtin_amdgcn_readfirstlane(F.tid >> 6);
    F.G = gridDim.x; { const int bx = blockIdx.x; F.vcu = (F.G % 8 == 0) ? (bx % 8) * (F.G / 8) + bx / 8 : bx; }
    unsigned char* ws = args.ws;
    F.ctl = (gu32*)(ws + WS_CTL);
    F.x = args.in[0]; F.norm_g = args.in[1]; F.w_in = args.in[2]; F.w_out = args.in[3]; F.conv_a_w = args.in[4]; F.conv_a_b = args.in[5]; F.ln_a_g = args.in[6]; F.ln_a_b = args.in[7];
    F.conv_b_w = args.in[8]; F.swa_sink = args.in[9]; F.na_rpb = args.in[10]; F.final_g = args.in[11]; F.out = args.out;
    F.Win_t = (bf16*)(ws + WS_WIN); F.Wout_t = (bf16*)(ws + WS_WOUT); F.XN = (bf16*)(ws + WS_XN); F.Y = (bf16*)(ws + WS_Y); F.IB = (bf16*)(ws + WS_I); F.rope = (f32x2*)(ws + WS_ROPE); F.ssqp = (float*)(ws + WS_SSQ);
    for (int u = F.tid; u < (LDS_BYTES - LDSCTL_OFF) / 4; u += NWAVES * 64) ((LAS unsigned*)(F.lds + LDSCTL_OFF))[u] = 0u;
    __syncthreads();
    XcdBarrier bar; bar.bar = (unsigned*)(F.ctl + CW_BAR); bar.x = 0; bar.st = nullptr;
    if (N_LAUNCHES == 1) bar = xcd_barrier_post((unsigned*)(F.ctl + CW_BAR), F.MISC + 8);
#define GRID_BAR() do { if (N_LAUNCHES == 1) xcd_barrier(bar); } while (0)
    const int lo = args.ph_lo, hi = args.ph_hi;
#define IN(k) (lo <= (k) && (k) < hi)
#define BOTH(k) (IN(k) && IN((k) + 1))

    if (IN(0)) { p0_prologue(F); if (BOTH(0)) GRID_BAR(); }
#pragma unroll 1
    for (int l = 0; l < DEPTH; ++l) {
        const int pb = 1 + 4 * l;
        if (IN(pb)) {
            pg8::Gemm g{F.XN, F.Win_t + (size_t)l * NIN * D, M, NIN, D}; pg8::StaticOrder S; S.init(M, NIN, F.G, (int)blockIdx.x);
            EpiInProj E{F.IB, F.rope, F.ssqp};
            pg8::gemm_phase<EpiInProj, pg8::StaticOrder, true, true>(F.lds + RING_OFF, g, S, E);
            if (BOTH(pb)) GRID_BAR();
        }
        if (IN(pb + 1)) {
            mixer_a(F, l); mixer_b(F, l); mixer_c(F, l); mixer_d(F, l);
            if (BOTH(pb + 1)) GRID_BAR();
        }
        if (IN(pb + 2)) {
            pg8::Gemm g{F.Y, F.Wout_t + (size_t)l * D * D, M, D, D}; pg8::StaticOrder S; S.init(M, D, F.G, (int)blockIdx.x);
            EpiOutProj E{l == 0 ? F.x : F.out, F.out, l + 1 < DEPTH ? F.XN : nullptr, F.ssqp};
            pg8::gemm_phase<EpiOutProj, pg8::StaticOrder, false, true>(F.lds + RING_OFF, g, S, E);
            if (BOTH(pb + 2)) GRID_BAR();
        }
        if (IN(pb + 3) && l + 1 == DEPTH) {
            const int tid_ = opaque_tid(), lane_ = tid_ & 63, wave_ = __builtin_amdgcn_readfirstlane(tid_ >> 6);
            const int gw = F.vcu * NWAVES + wave_, NGW = F.G * NWAVES;
            for (int m = gw; m < M; m += NGW) rms_row_final(lane_, F.out + (size_t)m * D, F.out + (size_t)m * D, F.final_g, F.ssqp, m);
        }
    }
#undef IN
#undef BOTH
}

extern "C" void kernel_launch(void* const* d_in, const int* in_sizes, int n_in, void* d_out, int out_size, void* d_ws, size_t ws_size, hipStream_t stream) {
    static int grid = 0;
    if (grid == 0) {
        if (n_in != 12 || in_sizes[0] != M * D || out_size != M * D || ws_size < WS_END) { fprintf(stderr, "kernel_launch: unexpected shapes (n_in %d, in0 %d, out %d, ws %zu); nothing launched\n", n_in, n_in > 0 ? in_sizes[0] : -1, out_size, ws_size); grid = -1; return; }
        int dev = 0, cus = 0, per_cu = 0;
        if (hipGetDevice(&dev) != hipSuccess || hipDeviceGetAttribute(&cus, hipDeviceAttributeMultiprocessorCount, dev) != hipSuccess) { grid = -1; return; }
        if (hipFuncSetAttribute((const void*)hymba_fwd, hipFuncAttributeMaxDynamicSharedMemorySize, LDS_BYTES) != hipSuccess) { fprintf(stderr, "kernel_launch: hipFuncSetAttribute failed\n"); grid = -1; return; }
        if (hipOccupancyMaxActiveBlocksPerMultiprocessor(&per_cu, (const void*)hymba_fwd, NWAVES * 64, LDS_BYTES) != hipSuccess || per_cu < 1)
            fprintf(stderr, "kernel_launch: note: occupancy query reports %d workgroups per CU\n", per_cu);
        (void)hipGetLastError();
        grid = cus;
    }
    if (grid < 0) return;
    if (hipMemsetAsync((char*)d_ws + WS_CTL, 0, CTL_ZERO_BYTES, stream) != hipSuccess) return;
    Args a{};
    for (int i = 0; i < 12; ++i) a.in[i] = (const float*)d_in[i];
    a.out = (float*)d_out; a.ws = (unsigned char*)d_ws;
    if (N_LAUNCHES == 1) {
        a.ph_lo = 0; a.ph_hi = N_PHASES; a.li = 0;
        hipLaunchKernelGGL(hymba_fwd, dim3(grid), dim3(NWAVES * 64), LDS_BYTES, stream, a);
    } else {
        for (int li = 0; li < N_PHASES; ++li) { a.ph_lo = li; a.ph_hi = li + 1; a.li = li;
            hipLaunchKernelGGL(hymba_fwd, dim3(grid), dim3(NWAVES * 64), LDS_BYTES, stream, a); }
    }
}
```

```cpp
#include <hip/hip_runtime.h>
#include <cstdio>
#include <cstdint>

#ifndef MK_N_LAUNCHES
#define MK_N_LAUNCHES 1
#endif

namespace pg8 {
#define PG8_LAS __attribute__((address_space(3)))
typedef unsigned short bf16_t;
typedef short bf16x8 __attribute__((ext_vector_type(8)));
typedef float f32x4 __attribute__((ext_vector_type(4)));
typedef unsigned u32x4 __attribute__((ext_vector_type(4)));
constexpr int BM = 256, BK = 64, HALF = 128, HTB = HALF * BK * 2  , STAGE_BYTES = 8 * HTB, NXCD = 8, WGM = 8;

__host__ __device__ __forceinline__ int lds_byte(int r, int c) { const int st = (r >> 4) * 2 + (c >> 5), rr = r & 15, cc = c & 31, ob = rr * 64 + cc * 2; return st * 1024 + (ob ^ (((ob >> 9) & 1) << 5)); }
__host__ __device__ __forceinline__ void stage_rc(int b, int& R, int& C) { const int st = b / 1024, sb = b % 1024, swz = sb ^ (((sb >> 9) & 1) << 5); R = (st >> 1) * 16 + swz / 64; C = (st & 1) * 32 + (swz % 64) / 2; }
__host__ __device__ __forceinline__ int perm32(int rho) { const int n = rho >> 4, i = rho & 15; return 8 * (i >> 2) + 4 * n + (i & 3); }

struct Unit { int pm, pn; };
struct Gemm { const bf16_t* A; const bf16_t* Bt; int M, N, K; };

struct StaticOrder {
    int nM, nN, nwg, G, c;
    __host__ __device__ void init(int M, int N, int G_, int c_) { nM = M / BM; nN = N / BM; nwg = nM * nN; G = G_; c = c_; }
    __host__ __device__ bool next(int i, Unit& u) const {
        const long L = (long)i * G + c; if (L >= nwg) return false;
        int wgid = (int)L; { const int q = nwg / NXCD, r = nwg % NXCD, xcd = wgid % NXCD, off = wgid / NXCD; wgid = (xcd < r ? xcd * (q + 1) : r * (q + 1) + (xcd - r) * q) + off; }
        const int nig = WGM * nN, gid = wgid / nig, fm = gid * WGM, gsz = (nM - fm) < WGM ? (nM - fm) : WGM;
        u.pm = fm + ((wgid % nig) % gsz); u.pn = (wgid % nig) / gsz; return true;
    }
    __device__ __forceinline__ void a_ready(const Unit&) const {}
    __device__ __forceinline__ void done(const Unit&) const {}
};

__device__ __forceinline__ unsigned cvt_pk_bf16(float lo, float hi) { unsigned r; asm volatile("v_cvt_pk_bf16_f32 %0, %1, %2" : "=v"(r) : "v"(lo), "v"(hi)); return r; }

template <class Epi, class Sched, bool ALIGN_EPI = false, bool SP2 = false>
__device__ __forceinline__ void gemm_phase(PG8_LAS unsigned char* lds, const Gemm g, const Sched& S, const Epi& E) {
    int tid = threadIdx.x; asm volatile("" : "+v"(tid));
    const int wid = __builtin_amdgcn_readfirstlane(tid >> 6), lane = tid & 63, wr = wid >> 2, wc = wid & 3, fr = lane & 15, fq = lane >> 4;
    const int K = g.K, nt = K / BK;
    unsigned voffA[2], voffB[2];
#pragma unroll
    for (int i = 0; i < 2; ++i) { int R, C; stage_rc(tid * 16 + i * 8192, R, C); const int Rb = Epi::PERM ? ((R & ~31) + perm32(R & 31)) : R;
        voffA[i] = (unsigned)(R * K + C) * 2u; voffB[i] = (unsigned)(Rb * K + C) * 2u; }
    const size_t kstep = (size_t)(BK * 2);
    const size_t hstep = (size_t)HALF * K * 2;
    const size_t tstep = 2 * hstep;
    const unsigned ldsw = (unsigned)wid * 1024u;
    const int aoff = lds_byte(wr * 64 + fr, fq * 8), boff = lds_byte(wc * 32 + fr, fq * 8);
#define PG8_SA(b, h) (((b) * 2 + (h)) * HTB)
#define PG8_SB(b, h) ((4 + (b) * 2 + (h)) * HTB)
#define PG8_STAGE(bufoff, gbase, voff) do { _Pragma("unroll") for (int _i = 0; _i < 2; ++_i) \
        __builtin_amdgcn_global_load_lds((const unsigned*)((const char*)(gbase) + (voff)[_i]), (PG8_LAS unsigned*)(lds + (bufoff) + ldsw + _i * 8192), 16, 0, 0); } while (0)
#define PG8_LDA(dst, b, h) do { _Pragma("unroll") for (int m = 0; m < 4; ++m) _Pragma("unroll") for (int k = 0; k < 2; ++k) dst[m][k] = *(const PG8_LAS bf16x8*)(lds + PG8_SA(b, h) + aoff + m * 2048 + k * 1024); } while (0)
#define PG8_LDB(dst, b, h) do { _Pragma("unroll") for (int n = 0; n < 2; ++n) _Pragma("unroll") for (int k = 0; k < 2; ++k) dst[n][k] = *(const PG8_LAS bf16x8*)(lds + PG8_SB(b, h) + boff + n * 2048 + k * 1024); } while (0)
#define PG8_MMA(ai, bj, At, Bt) do { __builtin_amdgcn_s_setprio(1); _Pragma("unroll") for (int m = 0; m < 4; ++m) _Pragma("unroll") for (int n = 0; n < 2; ++n) _Pragma("unroll") for (int k = 0; k < 2; ++k) \
        acc[ai][bj][m][n] = __builtin_amdgcn_mfma_f32_16x16x32_bf16(Bt[n][k], At[m][k], acc[ai][bj][m][n], 0, 0, 0); __builtin_amdgcn_s_setprio(0); } while (0)
#define PG8_WAIT_V(n) asm volatile("s_waitcnt vmcnt(" #n ")" ::: "memory")
#define PG8_WAIT_L(n) asm volatile("s_waitcnt lgkmcnt(" #n ")" ::: "memory")
#define PG8_BAR __builtin_amdgcn_s_barrier()
#define PG8_SCHED __builtin_amdgcn_sched_barrier(0)
    Unit cur, nxt; int ui = 0;
    if (!S.next(0, cur)) return;
    f32x4 acc[2][2][4][2];
#pragma unroll
    for (int a = 0; a < 2; ++a)
#pragma unroll
        for (int b = 0; b < 2; ++b)
#pragma unroll
            for (int m = 0; m < 4; ++m)
#pragma unroll
                for (int n = 0; n < 2; ++n) acc[a][b][m][n] = (f32x4){0.f, 0.f, 0.f, 0.f};
    bf16x8 At[4][2], B0[2][2], B1[2][2];
    const char* cA = (const char*)g.A + (size_t)cur.pm * tstep; const char* cB = (const char*)g.Bt + (size_t)cur.pn * tstep;
    S.a_ready(cur);
    if constexpr (SP2) {
        PG8_STAGE(PG8_SB(0, 0), cB, voffB); PG8_STAGE(PG8_SB(0, 1), cB + hstep, voffB); PG8_STAGE(PG8_SA(0, 0), cA, voffA); PG8_STAGE(PG8_SA(0, 1), cA + hstep, voffA);
        if (wr == 1) PG8_BAR;
        PG8_WAIT_V(2); PG8_BAR;
        PG8_STAGE(PG8_SB(1, 0), cB + kstep, voffB); PG8_STAGE(PG8_SA(1, 0), cA + kstep, voffA); PG8_STAGE(PG8_SB(1, 1), cB + hstep + kstep, voffB);
        PG8_WAIT_V(6); PG8_BAR;
    } else {
        PG8_STAGE(PG8_SB(0, 0), cB, voffB); PG8_STAGE(PG8_SA(0, 0), cA, voffA); PG8_STAGE(PG8_SB(0, 1), cB + hstep, voffB); PG8_STAGE(PG8_SA(0, 1), cA + hstep, voffA);
        if (wr == 1) PG8_BAR;
        PG8_WAIT_V(4); PG8_BAR;
        PG8_STAGE(PG8_SB(1, 0), cB + kstep, voffB); PG8_STAGE(PG8_SA(1, 0), cA + kstep, voffA); PG8_STAGE(PG8_SB(1, 1), cB + hstep + kstep, voffB);
        PG8_WAIT_V(6); PG8_BAR;
    }
    for (;;) {
        const bool has_next = S.next(ui + 1, nxt);
        const char* nA = has_next ? (const char*)g.A + (size_t)nxt.pm * tstep : cA; const char* nB = has_next ? (const char*)g.Bt + (size_t)nxt.pn * tstep : cB;
        for (int t = 0; t < nt; t += 2) {
            const bool last = (t == nt - 2);
            const char* a1 = cA + (size_t)(t + 1) * kstep;
            const char* a2 = last ? nA : cA + (size_t)(t + 2) * kstep; const char* b2 = last ? nB : cB + (size_t)(t + 2) * kstep;
            const char* a3 = a2 + kstep; const char* b3 = b2 + kstep;
            if (last && has_next) S.a_ready(nxt);
            if constexpr (SP2) {
            PG8_LDB(B0, 0, 0); PG8_LDB(B1, 0, 1); PG8_SCHED; PG8_LDA(At, 0, 0); PG8_STAGE(PG8_SA(1, 1), a1 + hstep, voffA);
            PG8_WAIT_V(8); PG8_WAIT_L(0); PG8_BAR; PG8_MMA(0, 0, At, B0); PG8_MMA(0, 1, At, B1); PG8_BAR; PG8_SCHED;
            PG8_LDA(At, 0, 1); PG8_STAGE(PG8_SB(0, 0), b2, voffB); PG8_STAGE(PG8_SB(0, 1), b2 + hstep, voffB); PG8_STAGE(PG8_SA(0, 0), a2, voffA);
            PG8_WAIT_V(8); PG8_WAIT_L(0); PG8_BAR; PG8_MMA(1, 0, At, B0); PG8_MMA(1, 1, At, B1); PG8_BAR; PG8_SCHED;
            PG8_LDB(B0, 1, 0); PG8_LDB(B1, 1, 1); PG8_SCHED; PG8_LDA(At, 1, 0); PG8_STAGE(PG8_SA(0, 1), a2 + hstep, voffA);
            PG8_WAIT_V(8); PG8_WAIT_L(0); PG8_BAR; PG8_MMA(0, 0, At, B0); PG8_MMA(0, 1, At, B1); PG8_BAR; PG8_SCHED;
            PG8_LDA(At, 1, 1); PG8_STAGE(PG8_SB(1, 0), b3, voffB); PG8_STAGE(PG8_SB(1, 1), b3 + hstep, voffB); PG8_STAGE(PG8_SA(1, 0), a3, voffA);
            PG8_WAIT_V(8); PG8_WAIT_L(0); PG8_BAR; PG8_MMA(1, 0, At, B0); PG8_MMA(1, 1, At, B1); PG8_BAR; PG8_SCHED;
            } else {
            PG8_LDB(B0, 0, 0); PG8_SCHED; PG8_LDA(At, 0, 0); PG8_STAGE(PG8_SA(1, 1), a1 + hstep, voffA);
            PG8_WAIT_L(8); PG8_BAR; PG8_WAIT_L(0); PG8_MMA(0, 0, At, B0); PG8_BAR; PG8_SCHED;
            PG8_LDB(B1, 0, 1); PG8_STAGE(PG8_SB(0, 0), b2, voffB);
            PG8_BAR; PG8_WAIT_L(0); PG8_MMA(0, 1, At, B1); PG8_BAR;
            PG8_LDA(At, 0, 1); PG8_STAGE(PG8_SA(0, 0), a2, voffA);
            PG8_BAR; PG8_WAIT_L(0); PG8_MMA(1, 0, At, B0); PG8_BAR; PG8_SCHED;
            PG8_STAGE(PG8_SB(0, 1), b2 + hstep, voffB);
            PG8_WAIT_V(6); PG8_BAR; PG8_MMA(1, 1, At, B1); PG8_BAR;
            PG8_LDB(B0, 1, 0); PG8_SCHED; PG8_LDA(At, 1, 0); PG8_STAGE(PG8_SA(0, 1), a2 + hstep, voffA);
            PG8_WAIT_L(8); PG8_BAR; PG8_WAIT_L(0); PG8_MMA(0, 0, At, B0); PG8_BAR; PG8_SCHED;
            PG8_LDB(B1, 1, 1); PG8_STAGE(PG8_SB(1, 0), b3, voffB);
            PG8_BAR; PG8_WAIT_L(0); PG8_MMA(0, 1, At, B1); PG8_BAR;
            PG8_LDA(At, 1, 1); PG8_STAGE(PG8_SA(1, 0), a3, voffA);
            PG8_BAR; PG8_WAIT_L(0); PG8_MMA(1, 0, At, B0); PG8_BAR; PG8_SCHED;
            PG8_STAGE(PG8_SB(1, 1), b3 + hstep, voffB);
            PG8_WAIT_V(6); PG8_BAR; PG8_MMA(1, 1, At, B1); PG8_BAR;
            }
        }
        if constexpr (ALIGN_EPI) { if (wr == 0) PG8_BAR; }
        if constexpr (!Epi::AFTER_DRAIN) { E(acc, cur, wr, wc, fr, fq); S.done(cur); }
        if (!has_next) break;
#pragma unroll
        for (int a = 0; a < 2; ++a)
#pragma unroll
            for (int b = 0; b < 2; ++b)
#pragma unroll
                for (int m = 0; m < 4; ++m)
#pragma unroll
                    for (int n = 0; n < 2; ++n) acc[a][b][m][n] = (f32x4){0.f, 0.f, 0.f, 0.f};
        cur = nxt; cA = nA; cB = nB; ++ui;
        if constexpr (ALIGN_EPI) { if (wr == 1) PG8_BAR; }
    }
    PG8_WAIT_V(0);
    if constexpr (!ALIGN_EPI) { if (wr == 0) PG8_BAR; }
    PG8_BAR;
    if constexpr (Epi::AFTER_DRAIN) { E.fused(acc, cur, wr, wc, fr, fq, lds, wid, lane); S.done(cur); }
#undef PG8_SA
#undef PG8_SB
#undef PG8_STAGE
#undef PG8_LDA
#undef PG8_LDB
#undef PG8_MMA
#undef PG8_WAIT_V
#undef PG8_WAIT_L
#undef PG8_BAR
#undef PG8_SCHED
}
}

constexpr int NWAVES = 8;
constexpr int N_LAUNCHES = MK_N_LAUNCHES;
constexpr int N_PHASES = 9;
constexpr int SEQ = 4096, NB = 4, M = NB * SEQ, D = 1024, NIN = 3584, DEPTH = 2;
constexpr float EPS = 1e-6f;
constexpr float LOG2E = 1.4426950408889634f;
constexpr float QSCALE = 0.125f * LOG2E;

constexpr size_t MiB = 1u << 20;
constexpr size_t WS_CTL = 0, CTL_ZERO_BYTES = 1 * MiB;
constexpr size_t WS_ROPE = 1 * MiB;
constexpr size_t WS_SSQ = 2 * MiB;
constexpr size_t WS_WIN = 4 * MiB;
constexpr size_t WS_WOUT = 18 * MiB;
constexpr size_t WS_XN = 24 * MiB;
constexpr size_t WS_Y = 56 * MiB;
constexpr size_t WS_I = 88 * MiB;
constexpr size_t WS_END = 176 * MiB;
enum { IB_H = 0, IB_AZ, IB_CX, IB_GB, IB_CQ, IB_CKV, IB_CZ, IB_DQ, IB_DK, IB_DV, IB_DZ, IB_N };
constexpr size_t IB_ELEMS = (size_t)M * 256;
constexpr int CW_TMO = 0, CW_CODE = 1;
constexpr int CW_BAR = 4096;

constexpr int RING_OFF = 0, RING_BYTES = 131072;
constexpr int LDSCTL_OFF = RING_BYTES, MISC_OFF = LDSCTL_OFF + 320;
constexpr int LDS_BYTES = 147456;

#define GAS __attribute__((address_space(1)))
#define LAS __attribute__((address_space(3)))
typedef unsigned short bf16;
typedef unsigned v4u __attribute__((ext_vector_type(4)));
typedef unsigned v2u __attribute__((ext_vector_type(2)));
typedef float f32x4 __attribute__((ext_vector_type(4)));
typedef float f32x2 __attribute__((ext_vector_type(2)));
typedef short bf16x8 __attribute__((ext_vector_type(8)));
typedef GAS unsigned gu32;
#define RLX_AGENT __ATOMIC_RELAXED, __HIP_MEMORY_SCOPE_AGENT
#define LDS_WAIT() asm volatile("s_waitcnt lgkmcnt(0)" ::: "memory")
#define VM_WAIT() asm volatile("s_waitcnt vmcnt(0)" ::: "memory")
__device__ __forceinline__ unsigned f2bf(float f) { unsigned u = __builtin_bit_cast(unsigned, f); return (u + 0x7fffu + ((u >> 16) & 1u)) >> 16; }
__device__ __forceinline__ unsigned pk2(float lo, float hi) { return f2bf(lo) | (f2bf(hi) << 16); }
__device__ __forceinline__ float bflo(unsigned w) { return __uint_as_float(w << 16); }
__device__ __forceinline__ float bfhi(unsigned w) { return __uint_as_float(w & 0xffff0000u); }
__device__ __forceinline__ float bf2f(bf16 v) { return __uint_as_float((unsigned)v << 16); }
__device__ __forceinline__ float sigmoidf_(float x) { return __builtin_amdgcn_rcpf(1.0f + __builtin_amdgcn_exp2f(-x * LOG2E)); }
__device__ __forceinline__ float siluf_(float x) { return x * sigmoidf_(x); }

#define XB_TMO      128
#define XB_XCNT(j)  (256  + 64 * (j))
#define XB_XSUB(j)  (1280 + 64 * (j))
#define XB_XGEN(j)  (2304 + 64 * (j))
#define XB_TOP      3328
#define XB_TOPGEN   3392
#define XCD_BAR_WORDS 3456
#define XB_SPIN_CAP (1u << 18)
__device__ __forceinline__ unsigned xb_ld(unsigned* p)              { return __hip_atomic_load(p, __ATOMIC_RELAXED, __HIP_MEMORY_SCOPE_AGENT); }
__device__ __forceinline__ unsigned xb_add(unsigned* p, unsigned v) { return __hip_atomic_fetch_add(p, v, __ATOMIC_RELAXED, __HIP_MEMORY_SCOPE_AGENT); }
__device__ __forceinline__ unsigned xb_xcc_id() { return (unsigned)__builtin_amdgcn_s_getreg((3 << 11) | 20) & 0xFu; }
#define XB_SPIN(cond, bar) do { unsigned _sp = 0; while (cond) { __builtin_amdgcn_s_sleep(1); \
    if ((++_sp & 255u) == 0u) { if (xb_ld(&(bar)[XB_TMO])) break; if (_sp > XB_SPIN_CAP) { atomicAdd(&(bar)[XB_TMO], 1u); break; } } } } while (0)
struct XcdBarrier { unsigned* bar; unsigned x; volatile LAS unsigned* st; };
__device__ __forceinline__ XcdBarrier xcd_barrier_post(unsigned* bar, volatile LAS unsigned* st) {
    XcdBarrier b; b.bar = bar; b.x = xb_xcc_id(); b.st = st;
    if (threadIdx.x == 0) (void)xb_add(&bar[XB_XCNT(b.x)], 1u);
    return b;
}
__device__ __forceinline__ void xcd_barrier_complete(unsigned* bar, unsigned x, unsigned& nloc, unsigned& nx) {
    const unsigned G = gridDim.x * gridDim.y * gridDim.z;
    unsigned sum, cnt, mine, sp = 0u;
    for (;;) {
        sum = 0u; cnt = 0u; mine = 0u;
#pragma unroll
        for (unsigned j = 0; j < 16; ++j) { const unsigned c = xb_ld(&bar[XB_XCNT(j)]); sum += c; cnt += (c > 0u) ? 1u : 0u; mine = (j == x) ? c : mine; }
        if (sum == G) break;
        __builtin_amdgcn_s_sleep(1);
        if ((++sp & 255u) == 0u) { if (xb_ld(&bar[XB_TMO])) break; if (sp > XB_SPIN_CAP) { atomicAdd(&bar[XB_TMO], 1u); break; } }
    }
    nloc = mine > 0u ? mine : 1u; nx = cnt > 0u ? cnt : 1u;
}
__device__ __forceinline__ void xcd_barrier(const XcdBarrier& b) {
    asm volatile("s_waitcnt vmcnt(0)" ::: "memory");
    __syncthreads();
    if (threadIdx.x == 0) {
        unsigned* bar = b.bar;
        __builtin_amdgcn_s_waitcnt(0);
        unsigned nloc = b.st[0], nx = b.st[1];
        if (nloc == 0u) { xcd_barrier_complete(bar, b.x, nloc, nx); b.st[0] = nloc; b.st[1] = nx; }
        const unsigned old = xb_add(&bar[XB_XSUB(b.x)], 1u);
        const unsigned gen = old / nloc;
        if (old + 1u == (gen + 1u) * nloc) {
            __builtin_amdgcn_fence(__ATOMIC_RELEASE, "agent");
            asm volatile("s_waitcnt vmcnt(0)" ::: "memory");
            const unsigned og = xb_add(&bar[XB_TOP], 1u);
            const unsigned tg = og / nx;
            if (og + 1u == (tg + 1u) * nx) xb_add(&bar[XB_TOPGEN], 1u);
            else XB_SPIN(xb_ld(&bar[XB_TOPGEN]) == tg, bar);
            __builtin_amdgcn_fence(__ATOMIC_ACQUIRE, "agent");
            xb_add(&bar[XB_XGEN(b.x)], 1u);
            asm volatile("s_waitcnt vmcnt(0)" ::: "memory");
        } else {
            XB_SPIN(xb_ld(&bar[XB_XGEN(b.x)]) == gen, bar);
            __builtin_amdgcn_fence(__ATOMIC_ACQUIRE, "agent");
            asm volatile("s_waitcnt vmcnt(0)" ::: "memory");
        }
    }
    __syncthreads();
}

struct Frame {
    LAS unsigned char* lds;
    volatile LAS unsigned* MISC;
    gu32* ctl;
    int tid, lane, wave;
    int vcu, G;
    const float* x; float* out;
    const float *norm_g, *w_in, *w_out, *conv_a_w, *conv_a_b, *ln_a_g, *ln_a_b, *conv_b_w, *swa_sink, *na_rpb, *final_g;
    bf16 *Win_t, *Wout_t, *XN, *Y, *IB;
    f32x2* rope; float* ssqp;
};

__device__ __forceinline__ int opaque_tid() { int t = threadIdx.x; asm volatile("" : "+v"(t)); return t; }
__device__ __forceinline__ float wave_sum(float v) {
#pragma unroll
    for (int o = 1; o < 64; o <<= 1) v += __shfl_xor(v, o);
    return v;
}
__device__ __forceinline__ float wave_max(float v) {
#pragma unroll
    for (int o = 1; o < 64; o <<= 1) v = fmaxf(v, __shfl_xor(v, o));
    return v;
}

__host__ __device__ __forceinline__ int sigma32(int nb  ) {
    const int pn = nb >> 3, g = nb & 7, half = g >> 2, jj = (g & 3) * 32;
    switch (pn) {
        case 0: return (half ? 256 : 0) + jj;
        case 1: return (half ? 256 : 0) + 128 + jj;
        case 2: return (half ? 1280 : 1024) + jj;
        case 3: return (half ? 1280 : 1024) + 128 + jj;
        case 4: return (half ? 1536 : 768) + jj;
        case 5: return (half ? 1536 : 768) + 128 + jj;
        case 6: return 512 + g * 32;
        case 7: return 1792 + 64 * (g & 3) + (half ? 32 : 0);
        case 8: return (g & 3) < 2 ? 2048 + 64 * (g & 3) + (half ? 32 : 0)
                                   : 2176 + 64 * half + 32 * ((g & 3) - 2);
        case 9: return 2304 + g * 32;
        case 10: return 2560 + g * 32;
        case 11: return 2816 + g * 32;
        case 12: return 3072 + g * 32;
        default: return 3328 + g * 32;
    }
}

__device__ __forceinline__ void p0_transpose_item(const float* W, int K, int N, bf16* WT, int k0, int nrow0, int src_col0, const float* gain, LAS float* scr, int lane) {
#pragma unroll 8
    for (int i = 0; i < 32; ++i) { const int kk = 2 * i + (lane >> 5); float w = W[(size_t)(k0 + kk) * N + src_col0 + (lane & 31)]; if (gain) w *= gain[k0 + kk]; scr[kk * 33 + (lane & 31)] = w; }
    LDS_WAIT(); asm volatile("" ::: "memory");
    const int c = lane & 7;
#pragma unroll
    for (int j = 0; j < 4; ++j) { const int n = (lane >> 3) + 8 * j; const LAS float* s = scr + (8 * c) * 33 + n;
        v4u o; o.x = pk2(s[0 * 33], s[1 * 33]); o.y = pk2(s[2 * 33], s[3 * 33]); o.z = pk2(s[4 * 33], s[5 * 33]); o.w = pk2(s[6 * 33], s[7 * 33]);
        *(GAS v4u*)(WT + (size_t)(nrow0 + n) * K + k0 + 8 * c) = o; }
    LDS_WAIT(); asm volatile("" ::: "memory");
}
__device__ __forceinline__ void row_to_bf16_ssq(int lane, const float* xrow, bf16* orow, float* ssqp, int m) {
    const GAS f32x4* xr = (const GAS f32x4*)xrow + lane;
    f32x4 v[4]; float s = 0.f;
#pragma unroll
    for (int j = 0; j < 4; ++j) { v[j] = xr[64 * j]; s += (v[j].x * v[j].x + v[j].y * v[j].y) + (v[j].z * v[j].z + v[j].w * v[j].w); }
    s = wave_sum(s);
    if (lane < 4) ssqp[(size_t)lane * M + m] = lane == 0 ? s : 0.f;
    GAS unsigned long long* o8 = (GAS unsigned long long*)orow + lane;
#pragma unroll
    for (int j = 0; j < 4; ++j) o8[64 * j] = (unsigned long long)pk2(v[j].x, v[j].y) | ((unsigned long long)pk2(v[j].z, v[j].w) << 32);
}
__device__ __forceinline__ void rms_row_final(int lane, const float* xrow, float* orow, const float* g, const float* ssqp, int m) {
    const GAS f32x4* xr = (const GAS f32x4*)xrow + lane;
    f32x4 v[4];
#pragma unroll
    for (int j = 0; j < 4; ++j) v[j] = xr[64 * j];
    const float rstd = 1.0f / sqrtf(((ssqp[m] + ssqp[M + m]) + (ssqp[2 * M + m] + ssqp[3 * M + m])) * (1.f / D) + EPS);
    GAS f32x4* o = (GAS f32x4*)orow + lane;
#pragma unroll
    for (int j = 0; j < 4; ++j) { const f32x4 gg = ((const GAS f32x4*)g)[lane + 64 * j]; o[64 * j] = v[j] * rstd * gg; }
}

__device__ __forceinline__ void p0_prologue(Frame& F) {
    const int tid_ = opaque_tid(), lane_ = tid_ & 63, wave_ = __builtin_amdgcn_readfirstlane(tid_ >> 6);
    LAS float* scr = (LAS float*)(F.lds + RING_OFF + wave_ * 16384);
    const int gw = F.vcu * NWAVES + wave_, NGW = F.G * NWAVES;
    constexpr int I_IN = (D / 64) * (NIN / 32), I_OUT = (D / 64) * (D / 32);
    constexpr int NITEMS = DEPTH * (I_IN + I_OUT);
    for (int it = gw; it < NITEMS; it += NGW) {
        int r = it; const int l = r / (I_IN + I_OUT); r -= l * (I_IN + I_OUT);
        if (r < I_IN) { const int nblk = NIN / 32, kb = r / nblk, nb = r % nblk;
            p0_transpose_item(F.w_in + (size_t)l * D * NIN, D, NIN, F.Win_t + (size_t)l * NIN * D, 64 * kb, 32 * nb, sigma32(nb), F.norm_g + l * D, scr, lane_); }
        else { r -= I_IN; const int nblk = D / 32, kb = r / nblk, nb = r % nblk;
            p0_transpose_item(F.w_out + (size_t)l * D * D, D, D, F.Wout_t + (size_t)l * D * D, 64 * kb, 32 * nb, 32 * nb, nullptr, scr, lane_); }
    }
    for (int i = gw * 64 + lane_; i < SEQ * 32; i += NGW * 64) {
        const int pos = i >> 5, d = i & 31;
        const float inv_freq = exp2f(-(float)d * (13.287712379549449f / 32.0f));
        const float ang = (float)pos * inv_freq;
        const double a = (double)ang; const double k = rint(a * 0.15915494309189535); const double rr = a - k * 6.283185307179586476925;
        F.rope[i] = (f32x2){(float)cos(rr), (float)sin(rr)};
    }
    for (int m = gw; m < M; m += NGW) row_to_bf16_ssq(lane_, F.x + (size_t)m * D, F.XN + (size_t)m * D, F.ssqp, m);
}

struct EpiInProj {
    static constexpr bool PERM = true, AFTER_DRAIN = false;
    bf16* IB; const f32x2* rope; const float* ssqp;
    __device__ __forceinline__ static v4u pack8(const f32x4 a, const f32x4 b) { v4u w; w.x = pg8::cvt_pk_bf16(a[0], a[1]); w.y = pg8::cvt_pk_bf16(a[2], a[3]); w.z = pg8::cvt_pk_bf16(b[0], b[1]); w.w = pg8::cvt_pk_bf16(b[2], b[3]); return w; }
    __device__ __forceinline__ void operator()(const f32x4 (&acc)[2][2][4][2], const pg8::Unit& u, int wr, int wc, int fr, int fq) const {
        const int pn = u.pn, row0 = u.pm * 256 + wr * 64 + fr, cl = wc * 32 + 8 * fq;
        float rs[2][4];
#pragma unroll
        for (int ai = 0; ai < 2; ++ai)
#pragma unroll
            for (int m = 0; m < 4; ++m) { const float* sp = ssqp + row0 + ai * 128 + m * 16; rs[ai][m] = 1.0f / sqrtf(((sp[0] + sp[M]) + (sp[2 * M] + sp[3 * M])) * (1.f / D) + EPS); }
        if (pn < 6) {
            bf16* O = IB + (size_t)(pn < 2 ? IB_H : pn < 4 ? IB_CX : IB_GB) * IB_ELEMS + 128 * (pn & 1) + cl;
#pragma unroll
            for (int ai = 0; ai < 2; ++ai)
#pragma unroll
                for (int m = 0; m < 4; ++m) {
                    f32x4 o[2];
#pragma unroll
                    for (int n = 0; n < 2; ++n) { const f32x4 a = acc[ai][0][m][n] * rs[ai][m], b = acc[ai][1][m][n] * rs[ai][m];
#pragma unroll
                        for (int i = 0; i < 4; ++i) o[n][i] = pn < 2 ? a[i] * sigmoidf_(b[i]) : pn < 4 ? a[i] * b[i] : a[i] * siluf_(b[i]); }
                    *(v4u*)(O + (size_t)(row0 + ai * 128 + m * 16) * 256) = pack8(o[0], o[1]);
                }
        } else if (pn == 7) {
            bf16* O = IB + (size_t)IB_CQ * IB_ELEMS + 64 * wc + 8 * fq;
#pragma unroll
            for (int ai = 0; ai < 2; ++ai)
#pragma unroll
                for (int m = 0; m < 4; ++m) { const int row = row0 + ai * 128 + m * 16; const f32x4* rp = (const f32x4*)(rope + (size_t)(row & (SEQ - 1)) * 32 + 8 * fq);
                    f32x4 o1[2], o2[2];
#pragma unroll
                    for (int n = 0; n < 2; ++n) { const f32x4 cs0 = rp[2 * n], cs1 = rp[2 * n + 1]; const f32x4 x1 = acc[ai][0][m][n] * (QSCALE * rs[ai][m]), x2 = acc[ai][1][m][n] * (QSCALE * rs[ai][m]);
                        o1[n][0] = x1[0] * cs0[0] - x2[0] * cs0[1]; o2[n][0] = x2[0] * cs0[0] + x1[0] * cs0[1];
                        o1[n][1] = x1[1] * cs0[2] - x2[1] * cs0[3]; o2[n][1] = x2[1] * cs0[2] + x1[1] * cs0[3];
                        o1[n][2] = x1[2] * cs1[0] - x2[2] * cs1[1]; o2[n][2] = x2[2] * cs1[0] + x1[2] * cs1[1];
                        o1[n][3] = x1[3] * cs1[2] - x2[3] * cs1[3]; o2[n][3] = x2[3] * cs1[2] + x1[3] * cs1[3]; }
                    *(v4u*)(O + (size_t)row * 256) = pack8(o1[0], o1[1]); *(v4u*)(O + (size_t)row * 256 + 32) = pack8(o2[0], o2[1]);
                    asm volatile("" ::: "memory"); }
        } else if (pn == 8) {
            if (wc < 2) {
                bf16* O = IB + (size_t)IB_CKV * IB_ELEMS + 64 * wc + 8 * fq;
#pragma unroll
                for (int ai = 0; ai < 2; ++ai)
#pragma unroll
                    for (int m = 0; m < 4; ++m) { const int row = row0 + ai * 128 + m * 16; const f32x4* rp = (const f32x4*)(rope + (size_t)(row & (SEQ - 1)) * 32 + 8 * fq);
                        f32x4 o1[2], o2[2];
#pragma unroll
                        for (int n = 0; n < 2; ++n) { const f32x4 cs0 = rp[2 * n], cs1 = rp[2 * n + 1]; const f32x4 x1 = acc[ai][0][m][n] * rs[ai][m], x2 = acc[ai][1][m][n] * rs[ai][m];
                            o1[n][0] = x1[0] * cs0[0] - x2[0] * cs0[1]; o2[n][0] = x2[0] * cs0[0] + x1[0] * cs0[1];
                            o1[n][1] = x1[1] * cs0[2] - x2[1] * cs0[3]; o2[n][1] = x2[1] * cs0[2] + x1[1] * cs0[3];
                            o1[n][2] = x1[2] * cs1[0] - x2[2] * cs1[1]; o2[n][2] = x2[2] * cs1[0] + x1[2] * cs1[1];
                            o1[n][3] = x1[3] * cs1[2] - x2[3] * cs1[3]; o2[n][3] = x2[3] * cs1[2] + x1[3] * cs1[3]; }
                        *(v4u*)(O + (size_t)row * 256) = pack8(o1[0], o1[1]); *(v4u*)(O + (size_t)row * 256 + 32) = pack8(o2[0], o2[1]);
                        asm volatile("" ::: "memory"); }
            } else {
                bf16* O = IB + (size_t)IB_CKV * IB_ELEMS + 128 + 32 * (wc - 2) + 8 * fq;
#pragma unroll
                for (int ai = 0; ai < 2; ++ai)
#pragma unroll
                    for (int m = 0; m < 4; ++m) { const int row = row0 + ai * 128 + m * 16;
#pragma unroll
                        for (int bj = 0; bj < 2; ++bj) *(v4u*)(O + (size_t)row * 256 + 64 * bj) = pack8(acc[ai][bj][m][0] * rs[ai][m], acc[ai][bj][m][1] * rs[ai][m]); }
            }
        } else {
            const int ib = pn == 6 ? IB_AZ : pn == 9 ? IB_CZ : pn == 10 ? IB_DQ : pn == 11 ? IB_DK : pn == 12 ? IB_DV : IB_DZ;
            const int mode = (pn == 6 || pn == 9 || pn == 13) ? 1 : (pn == 10 ? 2 : 0);
            bf16* O = IB + (size_t)ib * IB_ELEMS + cl;
#pragma unroll
            for (int ai = 0; ai < 2; ++ai)
#pragma unroll
                for (int m = 0; m < 4; ++m) { const int row = row0 + ai * 128 + m * 16;
#pragma unroll
                    for (int bj = 0; bj < 2; ++bj) { f32x4 v[2];
#pragma unroll
                        for (int n = 0; n < 2; ++n) { v[n] = acc[ai][bj][m][n] * rs[ai][m];
                            if (mode == 1) {
#pragma unroll
                                for (int i = 0; i < 4; ++i) v[n][i] = siluf_(v[n][i]); }
                            else if (mode == 2) v[n] = v[n] * QSCALE; }
                        *(v4u*)(O + (size_t)row * 256 + 128 * bj) = pack8(v[0], v[1]); } }
        }
    }
};
struct EpiOutProj {
    static constexpr bool PERM = true, AFTER_DRAIN = true;
    const float* base; float* out; bf16* xn; float* ssqp;
    __device__ __forceinline__ void fused(f32x4 (&acc)[2][2][4][2], const pg8::Unit& u, int wr, int wc, int fr, int fq, LAS unsigned char* lds, int wid, int lane) const {
        const int row0 = u.pm * 256 + wr * 64 + fr, col0 = u.pn * 256 + wc * 32 + 8 * fq;
        LAS float* P = (LAS float*)lds;
#pragma unroll
        for (int ai = 0; ai < 2; ++ai)
#pragma unroll
            for (int m = 0; m < 4; ++m) { const size_t off = (size_t)(row0 + ai * 128 + m * 16) * D + col0; float q = 0.f;
#pragma unroll
                for (int bj = 0; bj < 2; ++bj) { const f32x4 v0 = *(const f32x4*)(base + off + bj * 128) + acc[ai][bj][m][0], v1 = *(const f32x4*)(base + off + bj * 128 + 4) + acc[ai][bj][m][1];
                    *(f32x4*)(out + off + bj * 128) = v0; *(f32x4*)(out + off + bj * 128 + 4) = v1;
                    q += ((v0[0] * v0[0] + v0[1] * v0[1]) + (v0[2] * v0[2] + v0[3] * v0[3])) + ((v1[0] * v1[0] + v1[1] * v1[1]) + (v1[2] * v1[2] + v1[3] * v1[3]));
                    if (xn) *(v4u*)(xn + off + bj * 128) = EpiInProj::pack8(v0, v1); }
                q += __shfl_xor(q, 16); q += __shfl_xor(q, 32);
                if (fq == 0) P[(ai * 128 + wr * 64 + m * 16 + fr) * 4 + wc] = q;
                if (m & 1) asm volatile("" ::: "memory"); }
        asm volatile("s_waitcnt lgkmcnt(0)" ::: "memory"); __builtin_amdgcn_s_barrier(); asm volatile("" ::: "memory");
        const int t = wid * 64 + lane;
        if (t < 256) { const f32x4 p = *(const LAS f32x4*)(P + 4 * t); ssqp[(size_t)u.pn * M + u.pm * 256 + t] = (p[0] + p[1]) + (p[2] + p[3]); }
    }
};

__device__ __forceinline__ void mixer_a(Frame& F, int layer) {
    LAS unsigned char* lds = F.lds;
    const bf16* H = F.IB + (size_t)IB_H * IB_ELEMS; const bf16* AZ = F.IB + (size_t)IB_AZ * IB_ELEMS;
    const float* cw = F.conv_a_w + layer * 31 * 256; const float* cb = F.conv_a_b + layer * 256; const float* lg = F.ln_a_g + layer * 256; const float* lb = F.ln_a_b + layer * 256;
    const int tid_ = opaque_tid(), lane_ = tid_ & 63, wave_ = __builtin_amdgcn_readfirstlane(tid_ >> 6);
    const int cp = tid_ & 127, tq = tid_ >> 7;
    for (int u = F.vcu; u < M / 64; u += F.G) {
        const int t0 = u * 64, s0 = t0 & (SEQ - 1), bbase = t0 - s0;
        for (int c = tid_; c < 94 * 32; c += 512) { const int i = c >> 5, ch = c & 31, s = s0 - 15 + i; v4u v = (v4u){0u, 0u, 0u, 0u};
            if (s >= 0 && s < SEQ) v = *(const GAS v4u*)(H + (size_t)(bbase + s) * 256 + ch * 8);
            *(LAS v4u*)(lds + i * 512 + ch * 16) = v; }
        __syncthreads();
        {
            float w0[31], w1[31];
#pragma unroll
            for (int j = 0; j < 31; ++j) { const f32x2 w = *(const GAS f32x2*)(cw + j * 256 + 2 * cp); w0[j] = w.x; w1[j] = w.y; }
            const f32x2 bb = *(const GAS f32x2*)(cb + 2 * cp);
            float a0[16], a1[16];
#pragma unroll
            for (int o = 0; o < 16; ++o) { a0[o] = bb.x; a1[o] = bb.y; }
#pragma unroll
            for (int i = 0; i < 46; ++i) { const unsigned hv = *(const LAS unsigned*)(lds + (tq * 16 + i) * 512 + cp * 4); const float h0 = bflo(hv), h1 = bfhi(hv);
#pragma unroll
                for (int o = 0; o < 16; ++o) { const int j = i - o; if (j >= 0 && j <= 30) { a0[o] += w0[j] * h0; a1[o] += w1[j] * h1; } } }
#pragma unroll
            for (int o = 0; o < 16; ++o) *(LAS f32x2*)(lds + 49152 + ((tq * 16 + o) * 256 + 2 * cp) * 4) = (f32x2){a0[o], a1[o]};
        }
        __syncthreads();
        {
            const f32x4 g4 = *(const GAS f32x4*)(lg + 4 * lane_), b4 = *(const GAS f32x4*)(lb + 4 * lane_);
#pragma unroll 2
            for (int k = 0; k < 8; ++k) { const int tok = 8 * wave_ + k; const f32x4 xv = *(const LAS f32x4*)(lds + 49152 + (tok * 256 + 4 * lane_) * 4);
                const float mean = wave_sum((xv.x + xv.y) + (xv.z + xv.w)) * (1.f / 256.f); const f32x4 d = xv - mean;
                const float var = wave_sum((d.x * d.x + d.y * d.y) + (d.z * d.z + d.w * d.w)) * (1.f / 256.f); const float rstd = 1.0f / sqrtf(var + EPS);
                const f32x4 y = d * rstd * g4 + b4;
                const v2u az = *(const GAS v2u*)(AZ + (size_t)(t0 + tok) * 256 + 4 * lane_);
                v2u o; o.x = pk2(siluf_(y.x) * bflo(az.x), siluf_(y.y) * bfhi(az.x)); o.y = pk2(siluf_(y.z) * bflo(az.y), siluf_(y.w) * bfhi(az.y));
                *(GAS v2u*)(F.Y + (size_t)(t0 + tok) * D + 4 * lane_) = o; }
        }
        __syncthreads();
    }
}
__device__ __forceinline__ void mixer_b(Frame& F, int layer) {
    const bf16* CX = F.IB + (size_t)IB_CX * IB_ELEMS; const bf16* GB = F.IB + (size_t)IB_GB * IB_ELEMS; const float* w = F.conv_b_w + layer * 3 * 256;
    const int tid_ = opaque_tid();
    for (int it = F.vcu * 512 + tid_; it < M * 32; it += F.G * 512) { const int t = it >> 5, ch = (it & 31) * 8, s = t & (SEQ - 1);
        const v4u z = (v4u){0u, 0u, 0u, 0u};
        const v4u xm = s > 0 ? *(const GAS v4u*)(CX + (size_t)(t - 1) * 256 + ch) : z, x0 = *(const GAS v4u*)(CX + (size_t)t * 256 + ch), xp = s < SEQ - 1 ? *(const GAS v4u*)(CX + (size_t)(t + 1) * 256 + ch) : z;
        const v4u gb = *(const GAS v4u*)(GB + (size_t)t * 256 + ch);
        v4u o;
#pragma unroll
        for (int q = 0; q < 4; ++q) { const int c0 = ch + 2 * q;
            const float r0 = w[c0] * bflo(xm[q]) + w[256 + c0] * bflo(x0[q]) + w[512 + c0] * bflo(xp[q]);
            const float r1 = w[c0 + 1] * bfhi(xm[q]) + w[256 + c0 + 1] * bfhi(x0[q]) + w[512 + c0 + 1] * bfhi(xp[q]);
            o[q] = pk2(bflo(gb[q]) * r0, bfhi(gb[q]) * r1); }
        *(GAS v4u*)(F.Y + (size_t)t * D + 256 + ch) = o; }
}
typedef short v4i16_t __attribute__((ext_vector_type(4)));
constexpr int ATT_PITCH = 144;
struct AttnState { float m, l; f32x4 negm; f32x4 o[4]; };
constexpr float ATT_THR = 8.0f;
__device__ __forceinline__ bf16x8 vtr2(const LAS unsigned char* p) {
    const v4i16_t lo = __builtin_amdgcn_ds_read_tr16_b64_v4i16((LAS v4i16_t*)p), hi = __builtin_amdgcn_ds_read_tr16_b64_v4i16((LAS v4i16_t*)(p + 16 * ATT_PITCH));
    return (bf16x8){lo[0], lo[1], lo[2], lo[3], hi[0], hi[1], hi[2], hi[3]};
}
__device__ __forceinline__ void attn_init(AttnState& st, float m0, float l0) {
    st.m = m0; st.l = l0; st.negm = (f32x4){-m0, -m0, -m0, -m0};
#pragma unroll
    for (int dt = 0; dt < 4; ++dt) st.o[dt] = (f32x4){0.f, 0.f, 0.f, 0.f};
}
template <bool FIRST>
__device__ __forceinline__ void attn_step(AttnState& st, f32x4 s0, f32x4 s1, const bf16x8 (&vf)[4]) {
    float mx = fmaxf(fmaxf(fmaxf(s0[0], s0[1]), fmaxf(s0[2], s0[3])), fmaxf(fmaxf(s1[0], s1[1]), fmaxf(s1[2], s1[3])));
    if (FIRST || __any(mx > ATT_THR)) {
        mx = fmaxf(mx, __shfl_xor(mx, 16)); mx = fmaxf(mx, __shfl_xor(mx, 32));
        const float d = FIRST ? mx : fmaxf(mx, 0.f);
        if (!FIRST) { const float a = __builtin_amdgcn_exp2f(-d); st.l *= a;
#pragma unroll
            for (int dt = 0; dt < 4; ++dt) st.o[dt] = st.o[dt] * a; }
        st.m += d; st.negm = (f32x4){-st.m, -st.m, -st.m, -st.m}; s0 = s0 - d; s1 = s1 - d;
    }
    f32x4 p0, p1;
#pragma unroll
    for (int r = 0; r < 4; ++r) { p0[r] = __builtin_amdgcn_exp2f(s0[r]); p1[r] = __builtin_amdgcn_exp2f(s1[r]); }
    st.l += ((p0[0] + p0[1]) + (p0[2] + p0[3])) + ((p1[0] + p1[1]) + (p1[2] + p1[3]));
    v4u pw; pw.x = pg8::cvt_pk_bf16(p0[0], p0[1]); pw.y = pg8::cvt_pk_bf16(p0[2], p0[3]); pw.z = pg8::cvt_pk_bf16(p1[0], p1[1]); pw.w = pg8::cvt_pk_bf16(p1[2], p1[3]);
    const bf16x8 pf = __builtin_bit_cast(bf16x8, pw);
#pragma unroll
    for (int dt = 0; dt < 4; ++dt) st.o[dt] = __builtin_amdgcn_mfma_f32_16x16x32_bf16(vf[dt], pf, st.o[dt], 0, 0, 0);
}
__device__ __forceinline__ void attn_finish(const AttnState& st, const bf16* gate_row, bf16* out_row, int g) {
    float l = st.l; l += __shfl_xor(l, 16); l += __shfl_xor(l, 32); const float inv = 1.0f / l;
#pragma unroll
    for (int dt = 0; dt < 4; ++dt) { const v2u gz = *(const GAS v2u*)(gate_row + 16 * dt + 4 * g); const f32x4 o = st.o[dt] * inv;
        v2u w; w.x = pk2(o[0] * bflo(gz.x), o[1] * bfhi(gz.x)); w.y = pk2(o[2] * bflo(gz.y), o[3] * bfhi(gz.y));
        *(GAS v2u*)(out_row + 16 * dt + 4 * g) = w; }
}
#define MFMA16(a, b, c) __builtin_amdgcn_mfma_f32_16x16x32_bf16(a, b, c, 0, 0, 0)
__device__ __forceinline__ void mixer_c(Frame& F, int layer) {
    const bf16* CQ = F.IB + (size_t)IB_CQ * IB_ELEMS; const bf16* CKV = F.IB + (size_t)IB_CKV * IB_ELEMS; const bf16* CZ = F.IB + (size_t)IB_CZ * IB_ELEMS;
    const int tid_ = opaque_tid(), lane = tid_ & 63, wave_ = __builtin_amdgcn_readfirstlane(tid_ >> 6), g = lane >> 4, li = lane & 15;
    LAS unsigned char* Kl = F.lds; LAS unsigned char* Vl = F.lds + 384 * ATT_PITCH;
    for (int u = F.vcu; u < NB * 32 * 2; u += F.G) {
        const int kvh = u & 1, n = (u >> 1) & 31, b = u >> 6;
        const int tq0 = b * SEQ + n * 128, tk0 = tq0 - 128, kk_lo = n == 0 ? 128 : 0, kk_hi = n == 31 ? 255 : 383;
        __syncthreads();
#pragma unroll
        for (int it = 0; it < 6; ++it) { const int c = tid_ + 512 * it, row = c >> 3, ch = c & 7;
            if (row >= kk_lo && row <= kk_hi) { const bf16* src = CKV + (size_t)(tk0 + row) * 256 + 64 * kvh + 8 * ch;
                const v4u kv = *(const GAS v4u*)src, vv = *(const GAS v4u*)(src + 128);
                *(LAS v4u*)(Kl + row * ATT_PITCH + ch * 16) = kv; *(LAS v4u*)(Vl + row * ATT_PITCH + ch * 16) = vv; } }
        const int hq = 2 * kvh + (wave_ >> 2), wq = wave_ & 3;
        bf16x8 qf[2][2];
#pragma unroll
        for (int qt = 0; qt < 2; ++qt)
#pragma unroll
            for (int ks = 0; ks < 2; ++ks) qf[qt][ks] = *(const GAS bf16x8*)(CQ + (size_t)(tq0 + 32 * wq + 16 * qt + li) * 256 + 64 * hq + 32 * ks + 8 * g);
        const float sink = F.swa_sink[layer * 4 + hq] * LOG2E;
        AttnState st[2];
        attn_init(st[0], sink, g == 0 ? 1.0f : 0.0f); attn_init(st[1], sink, g == 0 ? 1.0f : 0.0f);
        __syncthreads();
#pragma unroll 1
        for (int s = 0; s < 9; ++s) { const int kb = 32 * wq + 32 * s; if (kb < kk_lo || kb > kk_hi) continue;
            bf16x8 kf[2][2], vf[4];
#pragma unroll
            for (int kt = 0; kt < 2; ++kt)
#pragma unroll
                for (int ks = 0; ks < 2; ++ks) kf[kt][ks] = *(const LAS bf16x8*)(Kl + (kb + 16 * kt + li) * ATT_PITCH + (32 * ks + 8 * g) * 2);
#pragma unroll
            for (int dt = 0; dt < 4; ++dt) vf[dt] = vtr2(Vl + (kb + 4 * g + (li >> 2)) * ATT_PITCH + (16 * dt + 4 * (li & 3)) * 2);
#pragma unroll
            for (int qt = 0; qt < 2; ++qt) {
                f32x4 s0 = MFMA16(kf[0][0], qf[qt][0], st[qt].negm); s0 = MFMA16(kf[0][1], qf[qt][1], s0);
                f32x4 s1 = MFMA16(kf[1][0], qf[qt][0], st[qt].negm); s1 = MFMA16(kf[1][1], qf[qt][1], s1);
                if (s == 0 || s == 8) { const int qrel = 16 * qt + li;
#pragma unroll
                    for (int r = 0; r < 4; ++r) { const int k0 = 4 * g + r, k1 = 16 + 4 * g + r;
                        const bool v0 = s == 0 ? k0 >= qrel : k0 <= qrel, v1 = s == 0 ? k1 >= qrel : k1 <= qrel;
                        s0[r] = v0 ? s0[r] : -INFINITY; s1[r] = v1 ? s1[r] : -INFINITY; } }
                attn_step<false>(st[qt], s0, s1, vf); }
        }
#pragma unroll
        for (int qt = 0; qt < 2; ++qt) { const size_t tok = (size_t)(tq0 + 32 * wq + 16 * qt + li);
            attn_finish(st[qt], CZ + tok * 256 + 64 * hq, F.Y + tok * D + 512 + 64 * hq, g); }
    }
}
constexpr int NA_BIAS_OFF = 11 * 64 * ATT_PITCH;
template <bool F0, bool F1, bool A0, bool A1>
__device__ __forceinline__ void na_step(AttnState& st0, AttnState& st1, const bf16x8 (&kf)[2][2], const bf16x8 (&qf)[2][2], const bf16x8 (&vf)[4], const LAS float* brow0, const LAS float* brow1, int g, int lo) {
    float bz0[4], bz1[4], by0[4], by1[4];
#pragma unroll
    for (int q = 0; q < 4; ++q) { if (A0) { bz0[q] = brow0[4 * g + q]; bz1[q] = brow0[16 + 4 * g + q]; } if (A1) { by0[q] = brow1[4 * g + q]; by1[q] = brow1[16 + 4 * g + q]; } }
    if (A0) { f32x4 s0 = MFMA16(kf[0][0], qf[0][0], st0.negm); s0 = MFMA16(kf[0][1], qf[0][1], s0); f32x4 s1 = MFMA16(kf[1][0], qf[0][0], st0.negm); s1 = MFMA16(kf[1][1], qf[0][1], s1);
#pragma unroll
        for (int q = 0; q < 4; ++q) { const int k0 = 4 * g + q, k1 = 16 + 4 * g + q;
            s0[q] = (k0 >= lo && k0 <= lo + 15) ? s0[q] + bz0[q] : -INFINITY; s1[q] = (k1 >= lo && k1 <= lo + 15) ? s1[q] + bz1[q] : -INFINITY; }
        attn_step<F0>(st0, s0, s1, vf); }
    if (A1) { f32x4 s0 = MFMA16(kf[0][0], qf[1][0], st1.negm); s0 = MFMA16(kf[0][1], qf[1][1], s0); f32x4 s1 = MFMA16(kf[1][0], qf[1][0], st1.negm); s1 = MFMA16(kf[1][1], qf[1][1], s1);
#pragma unroll
        for (int q = 0; q < 4; ++q) { const int k0 = 4 * g + q, k1 = 16 + 4 * g + q;
            s0[q] = (k0 >= lo && k0 <= lo + 15) ? s0[q] + by0[q] : -INFINITY; s1[q] = (k1 >= lo && k1 <= lo + 15) ? s1[q] + by1[q] : -INFINITY; }
        attn_step<F1>(st1, s0, s1, vf); }
}
__device__ __forceinline__ void mixer_d(Frame& F, int layer) {
    const bf16* DQ = F.IB + (size_t)IB_DQ * IB_ELEMS; const bf16* DK = F.IB + (size_t)IB_DK * IB_ELEMS; const bf16* DV = F.IB + (size_t)IB_DV * IB_ELEMS; const bf16* DZ = F.IB + (size_t)IB_DZ * IB_ELEMS;
    const int tid_ = opaque_tid(), lane = tid_ & 63, wave_ = __builtin_amdgcn_readfirstlane(tid_ >> 6), g = lane >> 4, li = lane & 15;
    LAS unsigned char* Vl = F.lds; LAS float* bias = (LAS float*)(F.lds + NA_BIAS_OFF);
    for (int u = F.vcu; u < NB * 4 * 16; u += F.G) {
        const int rq = u & 15, h = (u >> 4) & 3, b = u >> 6, ra = 4 * rq;
        const int lo_row = ra - 4 < 0 ? 0 : (ra - 4 > 56 ? 56 : ra - 4), hi_r0 = ra - 1 > 56 ? 56 : ra - 1  ;
        const int hi_row = (hi_r0 < 0 ? 0 : hi_r0) + 7, nrows = hi_row - lo_row + 1;
        const size_t tb = (size_t)b * SEQ;
        __syncthreads();
        for (int c = tid_; c < nrows * 64 * 8; c += 512) { const int row = c >> 3, ch = c & 7;
            *(LAS v4u*)(Vl + row * ATT_PITCH + ch * 16) = *(const GAS v4u*)(DV + (tb + lo_row * 64 + row) * 256 + 64 * h + 8 * ch); }
        for (int c = tid_; c < 544; c += 512) { const int e = c - 32; bias[c] = (e >= 0 && e < 465) ? F.na_rpb[(size_t)(layer * 4 + h) * 465 + e] * LOG2E : 0.f; }
        const int rpw = wave_ >> 2, qg = wave_ & 3, rA = ra + 2 * rpw, rB = rA + 1;
        const int r0A = rA - 4 < 0 ? 0 : (rA - 4 > 56 ? 56 : rA - 4), r0B = rB - 4 < 0 ? 0 : (rB - 4 > 56 ? 56 : rB - 4), dB = r0B - r0A;
        const int wc0 = qg == 0 ? 0 : qg == 1 ? 8 : qg == 2 ? 24 : 32;
        const int c = 16 * qg + li, c0 = c - 8 < 0 ? 0 : (c - 8 > 48 ? 48 : c - 8), lo = c0 - wc0;
        const size_t tokA = tb + rA * 64 + c, tokB = tokA + 64;
        bf16x8 qf[2][2];
#pragma unroll
        for (int ks = 0; ks < 2; ++ks) { qf[0][ks] = *(const GAS bf16x8*)(DQ + tokA * 256 + 64 * h + 32 * ks + 8 * g); qf[1][ks] = *(const GAS bf16x8*)(DQ + tokB * 256 + 64 * h + 32 * ks + 8 * g); }
        AttnState stA, stB; attn_init(stA, 0.f, 0.f); attn_init(stB, 0.f, 0.f);
        const bf16* kbase = DK + (tb + wc0 + li) * 256 + 64 * h + 8 * g;
        bf16x8 kfr[2][2][2];
#define NA_KLOAD(slot, j) do { const int kr_ = (r0A + (j)) > 63 ? 63 : (r0A + (j)); _Pragma("unroll") for (int kt = 0; kt < 2; ++kt) _Pragma("unroll") for (int ks = 0; ks < 2; ++ks) \
            kfr[slot][kt][ks] = *(const GAS bf16x8*)(kbase + (size_t)(kr_ * 64 + 16 * kt) * 256 + 32 * ks); } while (0)
        NA_KLOAD(0, 0); NA_KLOAD(1, 1);
        __syncthreads();
        const LAS float* bcol = bias + 32 + (wc0 - c + 15);
        const LAS unsigned char* vbase = Vl + ((r0A - lo_row) * 64 + wc0 + 4 * g + (li >> 2)) * ATT_PITCH + (4 * (li & 3)) * 2;
#define NA_STEP(j, F0, F1, A0, A1) do { bf16x8 vf[4]; _Pragma("unroll") for (int dt = 0; dt < 4; ++dt) vf[dt] = vtr2(vbase + (j) * 64 * ATT_PITCH + 32 * dt); \
            na_step<F0, F1, A0, A1>(stA, stB, kfr[(j) & 1], qf, vf, bcol + (r0A + (j) - rA + 7) * 31, bcol + (r0A + (j) - rB + 7) * 31, g, lo); } while (0)
        if (dB == 0) {
            NA_STEP(0, true, true, true, true);   NA_KLOAD(0, 2);
            NA_STEP(1, false, false, true, true); NA_KLOAD(1, 3);
            NA_STEP(2, false, false, true, true); NA_KLOAD(0, 4);
            NA_STEP(3, false, false, true, true); NA_KLOAD(1, 5);
            NA_STEP(4, false, false, true, true); NA_KLOAD(0, 6);
            NA_STEP(5, false, false, true, true); NA_KLOAD(1, 7);
            NA_STEP(6, false, false, true, true);
            NA_STEP(7, false, false, true, true);
        } else {
            NA_STEP(0, true, false, true, false); NA_KLOAD(0, 2);
            NA_STEP(1, false, true, true, true);  NA_KLOAD(1, 3);
            NA_STEP(2, false, false, true, true); NA_KLOAD(0, 4);
            NA_STEP(3, false, false, true, true); NA_KLOAD(1, 5);
            NA_STEP(4, false, false, true, true); NA_KLOAD(0, 6);
            NA_STEP(5, false, false, true, true); NA_KLOAD(1, 7);
            NA_STEP(6, false, false, true, true); NA_KLOAD(0, 8);
            NA_STEP(7, false, false, true, true);
            NA_STEP(8, false, false, false, true);
        }
#undef NA_STEP
#undef NA_KLOAD
        attn_finish(stA, DZ + tokA * 256 + 64 * h, F.Y + tokA * D + 768 + 64 * h, g);
        attn_finish(stB, DZ + tokB * 256 + 64 * h, F.Y + tokB * D + 768 + 64 * h, g);
    }
}

struct Args { const float* in[12]; float* out; unsigned char* ws; int ph_lo, ph_hi, li, pad; };
__global__ void __launch_bounds__(NWAVES * 64, 2) hymba_fwd(Args args) {
    extern __shared__ __attribute__((aligned(16))) unsigned char lds[];
    Frame F;
    F.lds = (LAS unsigned char*)lds;
    F.MISC = (volatile LAS unsigned*)(F.lds + MISC_OFF);
    F.tid = threadIdx.x; F.lane = F.tid & 63; F.wave = __builtin_amdgcn_readfirstlane(F.tid >> 6);
    F.G = gridDim.x; { const int bx = blockIdx.x; F.vcu = (F.G % 8 == 0) ? (bx % 8) * (F.G / 8) + bx / 8 : bx; }
    unsigned char* ws = args.ws;
    F.ctl = (gu32*)(ws + WS_CTL);
    F.x = args.in[0]; F.norm_g = args.in[1]; F.w_in = args.in[2]; F.w_out = args.in[3]; F.conv_a_w = args.in[4]; F.conv_a_b = args.in[5]; F.ln_a_g = args.in[6]; F.ln_a_b = args.in[7];
    F.conv_b_w = args.in[8]; F.swa_sink = args.in[9]; F.na_rpb = args.in[10]; F.final_g = args.in[11]; F.out = args.out;
    F.Win_t = (bf16*)(ws + WS_WIN); F.Wout_t = (bf16*)(ws + WS_WOUT); F.XN = (bf16*)(ws + WS_XN); F.Y = (bf16*)(ws + WS_Y); F.IB = (bf16*)(ws + WS_I); F.rope = (f32x2*)(ws + WS_ROPE); F.ssqp = (float*)(ws + WS_SSQ);
    for (int u = F.tid; u < (LDS_BYTES - LDSCTL_OFF) / 4; u += NWAVES * 64) ((LAS unsigned*)(F.lds + LDSCTL_OFF))[u] = 0u;
    __syncthreads();
    XcdBarrier bar; bar.bar = (unsigned*)(F.ctl + CW_BAR); bar.x = 0; bar.st = nullptr;
    if (N_LAUNCHES == 1) bar = xcd_barrier_post((unsigned*)(F.ctl + CW_BAR), F.MISC + 8);
#define GRID_BAR() do { if (N_LAUNCHES == 1) xcd_barrier(bar); } while (0)
    const int lo = args.ph_lo, hi = args.ph_hi;
#define IN(k) (lo <= (k) && (k) < hi)
#define BOTH(k) (IN(k) && IN((k) + 1))

    if (IN(0)) { p0_prologue(F); if (BOTH(0)) GRID_BAR(); }
#pragma unroll 1
    for (int l = 0; l < DEPTH; ++l) {
        const int pb = 1 + 4 * l;
        if (IN(pb)) {
            pg8::Gemm g{F.XN, F.Win_t + (size_t)l * NIN * D, M, NIN, D}; pg8::StaticOrder S; S.init(M, NIN, F.G, (int)blockIdx.x);
            EpiInProj E{F.IB, F.rope, F.ssqp};
            pg8::gemm_phase<EpiInProj, pg8::StaticOrder, true, true>(F.lds + RING_OFF, g, S, E);
            if (BOTH(pb)) GRID_BAR();
        }
        if (IN(pb + 1)) {
            mixer_a(F, l); mixer_b(F, l); mixer_c(F, l); mixer_d(F, l);
            if (BOTH(pb + 1)) GRID_BAR();
        }
        if (IN(pb + 2)) {
            pg8::Gemm g{F.Y, F.Wout_t + (size_t)l * D * D, M, D, D}; pg8::StaticOrder S; S.init(M, D, F.G, (int)blockIdx.x);
            EpiOutProj E{l == 0 ? F.x : F.out, F.out, l + 1 < DEPTH ? F.XN : nullptr, F.ssqp};
            pg8::gemm_phase<EpiOutProj, pg8::StaticOrder, false, true>(F.lds + RING_OFF, g, S, E);
            if (BOTH(pb + 2)) GRID_BAR();
        }
        if (IN(pb + 3) && l + 1 == DEPTH) {
            const int tid_ = opaque_tid(), lane_ = tid_ & 63, wave_ = __builtin_amdgcn_readfirstlane(tid_ >> 6);
            const int gw = F.vcu * NWAVES + wave_, NGW = F.G * NWAVES;
            for (int m = gw; m < M; m += NGW) rms_row_final(lane_, F.out + (size_t)m * D, F.out + (size_t)m * D, F.final_g, F.ssqp, m);
        }
    }
#undef IN
#undef BOTH
}

extern "C" void kernel_launch(void* const* d_in, const int* in_sizes, int n_in, void* d_out, int out_size, void* d_ws, size_t ws_size, hipStream_t stream) {
    static int grid = 0;
    if (grid == 0) {
        if (n_in != 12 || in_sizes[0] != M * D || out_size != M * D || ws_size < WS_END) { fprintf(stderr, "kernel_launch: unexpected shapes (n_in %d, in0 %d, out %d, ws %zu); nothing launched\n", n_in, n_in > 0 ? in_sizes[0] : -1, out_size, ws_size); grid = -1; return; }
        int dev = 0, cus = 0, per_cu = 0;
        if (hipGetDevice(&dev) != hipSuccess || hipDeviceGetAttribute(&cus, hipDeviceAttributeMultiprocessorCount, dev) != hipSuccess) { grid = -1; return; }
        if (hipFuncSetAttribute((const void*)hymba_fwd, hipFuncAttributeMaxDynamicSharedMemorySize, LDS_BYTES) != hipSuccess) { fprintf(stderr, "kernel_launch: hipFuncSetAttribute failed\n"); grid = -1; return; }
        if (hipOccupancyMaxActiveBlocksPerMultiprocessor(&per_cu, (const void*)hymba_fwd, NWAVES * 64, LDS_BYTES) != hipSuccess || per_cu < 1)
            fprintf(stderr, "kernel_launch: note: occupancy query reports %d workgroups per CU\n", per_cu);
        (void)hipGetLastError();
        grid = cus;
    }
    if (grid < 0) return;
    if (hipMemsetAsync((char*)d_ws + WS_CTL, 0, CTL_ZERO_BYTES, stream) != hipSuccess) return;
    Args a{};
    for (int i = 0; i < 12; ++i) a.in[i] = (const float*)d_in[i];
    a.out = (float*)d_out; a.ws = (unsigned char*)d_ws;
    if (N_LAUNCHES == 1) {
        a.ph_lo = 0; a.ph_hi = N_PHASES; a.li = 0;
        hipLaunchKernelGGL(hymba_fwd, dim3(grid), dim3(NWAVES * 64), LDS_BYTES, stream, a);
    } else {
        for (int li = 0; li < N_PHASES; ++li) { a.ph_lo = li; a.ph_hi = li + 1; a.li = li;
            hipLaunchKernelGGL(hymba_fwd, dim3(grid), dim3(NWAVES * 64), LDS_BYTES, stream, a); }
    }
}
```

```cpp
#include <hip/hip_runtime.h>
#include <cstdio>
#include <cstdint>

#ifndef MK_N_LAUNCHES
#define MK_N_LAUNCHES 1
#endif

namespace pg8 {
#define PG8_LAS __attribute__((address_space(3)))
typedef unsigned short bf16_t;
typedef short bf16x8 __attribute__((ext_vector_type(8)));
typedef float f32x4 __attribute__((ext_vector_type(4)));
typedef unsigned u32x4 __attribute__((ext_vector_type(4)));
constexpr int BM = 256, BK = 64, HALF = 128, HTB = HALF * BK * 2  , STAGE_BYTES = 8 * HTB, NXCD = 8, WGM = 8;

__host__ __device__ __forceinline__ int lds_byte(int r, int c) { const int st = (r >> 4) * 2 + (c >> 5), rr = r & 15, cc = c & 31, ob = rr * 64 + cc * 2; return st * 1024 + (ob ^ (((ob >> 9) & 1) << 5)); }
__host__ __device__ __forceinline__ void stage_rc(int b, int& R, int& C) { const int st = b / 1024, sb = b % 1024, swz = sb ^ (((sb >> 9) & 1) << 5); R = (st >> 1) * 16 + swz / 64; C = (st & 1) * 32 + (swz % 64) / 2; }
__host__ __device__ __forceinline__ int perm32(int rho) { const int n = rho >> 4, i = rho & 15; return 8 * (i >> 2) + 4 * n + (i & 3); }

struct Unit { int pm, pn; };
struct Gemm { const bf16_t* A; const bf16_t* Bt; int M, N, K; };

struct StaticOrder {
    int nM, nN, nwg, G, c;
    __host__ __device__ void init(int M, int N, int G_, int c_) { nM = M / BM; nN = N / BM; nwg = nM * nN; G = G_; c = c_; }
    __host__ __device__ bool next(int i, Unit& u) const {
        const long L = (long)i * G + c; if (L >= nwg) return false;
        int wgid = (int)L; { const int q = nwg / NXCD, r = nwg % NXCD, xcd = wgid % NXCD, off = wgid / NXCD; wgid = (xcd < r ? xcd * (q + 1) : r * (q + 1) + (xcd - r) * q) + off; }
        const int nig = WGM * nN, gid = wgid / nig, fm = gid * WGM, gsz = (nM - fm) < WGM ? (nM - fm) : WGM;
        u.pm = fm + ((wgid % nig) % gsz); u.pn = (wgid % nig) / gsz; return true;
    }
    __device__ __forceinline__ void a_ready(const Unit&) const {}
    __device__ __forceinline__ void done(const Unit&) const {}
};

__device__ __forceinline__ unsigned cvt_pk_bf16(float lo, float hi) { unsigned r; asm volatile("v_cvt_pk_bf16_f32 %0, %1, %2" : "=v"(r) : "v"(lo), "v"(hi)); return r; }

template <class Epi, class Sched, bool ALIGN_EPI = false, bool SP2 = false>
__device__ __forceinline__ void gemm_phase(PG8_LAS unsigned char* lds, const Gemm g, const Sched& S, const Epi& E) {
    int tid = threadIdx.x; asm volatile("" : "+v"(tid));
    const int wid = __builtin_amdgcn_readfirstlane(tid >> 6), lane = tid & 63, wr = wid >> 2, wc = wid & 3, fr = lane & 15, fq = lane >> 4;
    const int K = g.K, nt = K / BK;
    unsigned voffA[2], voffB[2];
#pragma unroll
    for (int i = 0; i < 2; ++i) { int R, C; stage_rc(tid * 16 + i * 8192, R, C); const int Rb = Epi::PERM ? ((R & ~31) + perm32(R & 31)) : R;
        voffA[i] = (unsigned)(R * K + C) * 2u; voffB[i] = (unsigned)(Rb * K + C) * 2u; }
    const size_t kstep = (size_t)(BK * 2);
    const size_t hstep = (size_t)HALF * K * 2;
    const size_t tstep = 2 * hstep;
    const unsigned ldsw = (unsigned)wid * 1024u;
    const int aoff = lds_byte(wr * 64 + fr, fq * 8), boff = lds_byte(wc * 32 + fr, fq * 8);
#define PG8_SA(b, h) (((b) * 2 + (h)) * HTB)
#define PG8_SB(b, h) ((4 + (b) * 2 + (h)) * HTB)
#define PG8_STAGE(bufoff, gbase, voff) do { _Pragma("unroll") for (int _i = 0; _i < 2; ++_i) \
        __builtin_amdgcn_global_load_lds((const unsigned*)((const char*)(gbase) + (voff)[_i]), (PG8_LAS unsigned*)(lds + (bufoff) + ldsw + _i * 8192), 16, 0, 0); } while (0)
#define PG8_LDA(dst, b, h) do { _Pragma("unroll") for (int m = 0; m < 4; ++m) _Pragma("unroll") for (int k = 0; k < 2; ++k) dst[m][k] = *(const PG8_LAS bf16x8*)(lds + PG8_SA(b, h) + aoff + m * 2048 + k * 1024); } while (0)
#define PG8_LDB(dst, b, h) do { _Pragma("unroll") for (int n = 0; n < 2; ++n) _Pragma("unroll") for (int k = 0; k < 2; ++k) dst[n][k] = *(const PG8_LAS bf16x8*)(lds + PG8_SB(b, h) + boff + n * 2048 + k * 1024); } while (0)
#define PG8_MMA(ai, bj, At, Bt) do { __builtin_amdgcn_s_setprio(1); _Pragma("unroll") for (int m = 0; m < 4; ++m) _Pragma("unroll") for (int n = 0; n < 2; ++n) _Pragma("unroll") for (int k = 0; k < 2; ++k) \
        acc[ai][bj][m][n] = __builtin_amdgcn_mfma_f32_16x16x32_bf16(Bt[n][k], At[m][k], acc[ai][bj][m][n], 0, 0, 0); __builtin_amdgcn_s_setprio(0); } while (0)
#define PG8_WAIT_V(n) asm volatile("s_waitcnt vmcnt(" #n ")" ::: "memory")
#define PG8_WAIT_L(n) asm volatile("s_waitcnt lgkmcnt(" #n ")" ::: "memory")
#define PG8_BAR __builtin_amdgcn_s_barrier()
#define PG8_SCHED __builtin_amdgcn_sched_barrier(0)
    Unit cur, nxt; int ui = 0;
    if (!S.next(0, cur)) return;
    f32x4 acc[2][2][4][2];
#pragma unroll
    for (int a = 0; a < 2; ++a)
#pragma unroll
        for (int b = 0; b < 2; ++b)
#pragma unroll
            for (int m = 0; m < 4; ++m)
#pragma unroll
                for (int n = 0; n < 2; ++n) acc[a][b][m][n] = (f32x4){0.f, 0.f, 0.f, 0.f};
    bf16x8 At[4][2], B0[2][2], B1[2][2];
    const char* cA = (const char*)g.A + (size_t)cur.pm * tstep; const char* cB = (const char*)g.Bt + (size_t)cur.pn * tstep;
    S.a_ready(cur);
    if constexpr (SP2) {
        PG8_STAGE(PG8_SB(0, 0), cB, voffB); PG8_STAGE(PG8_SB(0, 1), cB + hstep, voffB); PG8_STAGE(PG8_SA(0, 0), cA, voffA); PG8_STAGE(PG8_SA(0, 1), cA + hstep, voffA);
        if (wr == 1) PG8_BAR;
        PG8_WAIT_V(2); PG8_BAR;
        PG8_STAGE(PG8_SB(1, 0), cB + kstep, voffB); PG8_STAGE(PG8_SA(1, 0), cA + kstep, voffA); PG8_STAGE(PG8_SB(1, 1), cB + hstep + kstep, voffB);
        PG8_WAIT_V(6); PG8_BAR;
    } else {
        PG8_STAGE(PG8_SB(0, 0), cB, voffB); PG8_STAGE(PG8_SA(0, 0), cA, voffA); PG8_STAGE(PG8_SB(0, 1), cB + hstep, voffB); PG8_STAGE(PG8_SA(0, 1), cA + hstep, voffA);
        if (wr == 1) PG8_BAR;
        PG8_WAIT_V(4); PG8_BAR;
        PG8_STAGE(PG8_SB(1, 0), cB + kstep, voffB); PG8_STAGE(PG8_SA(1, 0), cA + kstep, voffA); PG8_STAGE(PG8_SB(1, 1), cB + hstep + kstep, voffB);
        PG8_WAIT_V(6); PG8_BAR;
    }
    for (;;) {
        const bool has_next = S.next(ui + 1, nxt);
        const char* nA = has_next ? (const char*)g.A + (size_t)nxt.pm * tstep : cA; const char* nB = has_next ? (const char*)g.Bt + (size_t)nxt.pn * tstep : cB;
        for (int t = 0; t < nt; t += 2) {
            const bool last = (t == nt - 2);
            const char* a1 = cA + (size_t)(t + 1) * kstep;
            const char* a2 = last ? nA : cA + (size_t)(t + 2) * kstep; const char* b2 = last ? nB : cB + (size_t)(t + 2) * kstep;
            const char* a3 = a2 + kstep; const char* b3 = b2 + kstep;
            if (last && has_next) S.a_ready(nxt);
            if constexpr (SP2) {
            PG8_LDB(B0, 0, 0); PG8_LDB(B1, 0, 1); PG8_SCHED; PG8_LDA(At, 0, 0); PG8_STAGE(PG8_SA(1, 1), a1 + hstep, voffA);
            PG8_WAIT_V(8); PG8_WAIT_L(0); PG8_BAR; PG8_MMA(0, 0, At, B0); PG8_MMA(0, 1, At, B1); PG8_BAR; PG8_SCHED;
            PG8_LDA(At, 0, 1); PG8_STAGE(PG8_SB(0, 0), b2, voffB); PG8_STAGE(PG8_SB(0, 1), b2 + hstep, voffB); PG8_STAGE(PG8_SA(0, 0), a2, voffA);
            PG8_WAIT_V(8); PG8_WAIT_L(0); PG8_BAR; PG8_MMA(1, 0, At, B0); PG8_MMA(1, 1, At, B1); PG8_BAR; PG8_SCHED;
            PG8_LDB(B0, 1, 0); PG8_LDB(B1, 1, 1); PG8_SCHED; PG8_LDA(At, 1, 0); PG8_STAGE(PG8_SA(0, 1), a2 + hstep, voffA);
            PG8_WAIT_V(8); PG8_WAIT_L(0); PG8_BAR; PG8_MMA(0, 0, At, B0); PG8_MMA(0, 1, At, B1); PG8_BAR; PG8_SCHED;
            PG8_LDA(At, 1, 1); PG8_STAGE(PG8_SB(1, 0), b3, voffB); PG8_STAGE(PG8_SB(1, 1), b3 + hstep, voffB); PG8_STAGE(PG8_SA(1, 0), a3, voffA);
            PG8_WAIT_V(8); PG8_WAIT_L(0); PG8_BAR; PG8_MMA(1, 0, At, B0); PG8_MMA(1, 1, At, B1); PG8_BAR; PG8_SCHED;
            } else {
            PG8_LDB(B0, 0, 0); PG8_SCHED; PG8_LDA(At, 0, 0); PG8_STAGE(PG8_SA(1, 1), a1 + hstep, voffA);
            PG8_WAIT_L(8); PG8_BAR; PG8_WAIT_L(0); PG8_MMA(0, 0, At, B0); PG8_BAR; PG8_SCHED;
            PG8_LDB(B1, 0, 1); PG8_STAGE(PG8_SB(0, 0), b2, voffB);
            PG8_BAR; PG8_WAIT_L(0); PG8_MMA(0, 1, At, B1); PG8_BAR;
            PG8_LDA(At, 0, 1); PG8_STAGE(PG8_SA(0, 0), a2, voffA);
            PG8_BAR; PG8_WAIT_L(0); PG8_MMA(1, 0, At, B0); PG8_BAR; PG8_SCHED;
            PG8_STAGE(PG8_SB(0, 1), b2 + hstep, voffB);
            PG8_WAIT_V(6); PG8_BAR; PG8_MMA(1, 1, At, B1); PG8_BAR;
            PG8_LDB(B0, 1, 0); PG8_SCHED; PG8_LDA(At, 1, 0); PG8_STAGE(PG8_SA(0, 1), a2 + hstep, voffA);
            PG8_WAIT_L(8); PG8_BAR; PG8_WAIT_L(0); PG8_MMA(0, 0, At, B0); PG8_BAR; PG8_SCHED;
            PG8_LDB(B1, 1, 1); PG8_STAGE(PG8_SB(1, 0), b3, voffB);
            PG8_BAR; PG8_WAIT_L(0); PG8_MMA(0, 1, At, B1); PG8_BAR;
            PG8_LDA(At, 1, 1); PG8_STAGE(PG8_SA(1, 0), a3, voffA);
            PG8_BAR; PG8_WAIT_L(0); PG8_MMA(1, 0, At, B0); PG8_BAR; PG8_SCHED;
            PG8_STAGE(PG8_SB(1, 1), b3 + hstep, voffB);
            PG8_WAIT_V(6); PG8_BAR; PG8_MMA(1, 1, At, B1); PG8_BAR;
            }
        }
        if constexpr (ALIGN_EPI) { if (wr == 0) PG8_BAR; }
        if constexpr (!Epi::AFTER_DRAIN) { E(acc, cur, wr, wc, fr, fq); S.done(cur); }
        if (!has_next) break;
#pragma unroll
        for (int a = 0; a < 2; ++a)
#pragma unroll
            for (int b = 0; b < 2; ++b)
#pragma unroll
                for (int m = 0; m < 4; ++m)
#pragma unroll
                    for (int n = 0; n < 2; ++n) acc[a][b][m][n] = (f32x4){0.f, 0.f, 0.f, 0.f};
        cur = nxt; cA = nA; cB = nB; ++ui;
        if constexpr (ALIGN_EPI) { if (wr == 1) PG8_BAR; }
    }
    PG8_WAIT_V(0);
    if constexpr (!ALIGN_EPI) { if (wr == 0) PG8_BAR; }
    PG8_BAR;
    if constexpr (Epi::AFTER_DRAIN) { E.fused(acc, cur, wr, wc, fr, fq, lds, wid, lane); S.done(cur); }
#undef PG8_SA
#undef PG8_SB
#undef PG8_STAGE
#undef PG8_LDA
#undef PG8_LDB
#undef PG8_MMA
#undef PG8_WAIT_V
#undef PG8_WAIT_L
#undef PG8_BAR
#undef PG8_SCHED
}
}

constexpr int NWAVES = 8;
constexpr int N_LAUNCHES = MK_N_LAUNCHES;
constexpr int N_PHASES = 9;
constexpr int SEQ = 4096, NB = 4, M = NB * SEQ, D = 1024, NIN = 3584, DEPTH = 2;
constexpr float EPS = 1e-6f;
constexpr float LOG2E = 1.4426950408889634f;
constexpr float QSCALE = 0.125f * LOG2E;

constexpr size_t MiB = 1u << 20;
constexpr size_t WS_CTL = 0, CTL_ZERO_BYTES = 1 * MiB;
constexpr size_t WS_ROPE = 1 * MiB;
constexpr size_t WS_SSQ = 2 * MiB;
constexpr size_t WS_WIN = 4 * MiB;
constexpr size_t WS_WOUT = 18 * MiB;
constexpr size_t WS_XN = 24 * MiB;
constexpr size_t WS_Y = 56 * MiB;
constexpr size_t WS_I = 88 * MiB;
constexpr size_t WS_END = 176 * MiB;
enum { IB_H = 0, IB_AZ, IB_CX, IB_GB, IB_CQ, IB_CKV, IB_CZ, IB_DQ, IB_DK, IB_DV, IB_DZ, IB_N };
constexpr size_t IB_ELEMS = (size_t)M * 256;
constexpr int CW_TMO = 0, CW_CODE = 1;
constexpr int CW_BAR = 4096;

constexpr int RING_OFF = 0, RING_BYTES = 131072;
constexpr int LDSCTL_OFF = RING_BYTES, MISC_OFF = LDSCTL_OFF + 320;
constexpr int LDS_BYTES = 147456;

#define GAS __attribute__((address_space(1)))
#define LAS __attribute__((address_space(3)))
typedef unsigned short bf16;
typedef unsigned v4u __attribute__((ext_vector_type(4)));
typedef unsigned v2u __attribute__((ext_vector_type(2)));
typedef float f32x4 __attribute__((ext_vector_type(4)));
typedef float f32x2 __attribute__((ext_vector_type(2)));
typedef short bf16x8 __attribute__((ext_vector_type(8)));
typedef GAS unsigned gu32;
#define RLX_AGENT __ATOMIC_RELAXED, __HIP_MEMORY_SCOPE_AGENT
#define LDS_WAIT() asm volatile("s_waitcnt lgkmcnt(0)" ::: "memory")
#define VM_WAIT() asm volatile("s_waitcnt vmcnt(0)" ::: "memory")
__device__ __forceinline__ unsigned f2bf(float f) { unsigned u = __builtin_bit_cast(unsigned, f); return (u + 0x7fffu + ((u >> 16) & 1u)) >> 16; }
__device__ __forceinline__ unsigned pk2(float lo, float hi) { return f2bf(lo) | (f2bf(hi) << 16); }
__device__ __forceinline__ float bflo(unsigned w) { return __uint_as_float(w << 16); }
__device__ __forceinline__ float bfhi(unsigned w) { return __uint_as_float(w & 0xffff0000u); }
__device__ __forceinline__ float bf2f(bf16 v) { return __uint_as_float((unsigned)v << 16); }
__device__ __forceinline__ float sigmoidf_(float x) { return __builtin_amdgcn_rcpf(1.0f + __builtin_amdgcn_exp2f(-x * LOG2E)); }
__device__ __forceinline__ float siluf_(float x) { return x * sigmoidf_(x); }

#define XB_TMO      128
#define XB_XCNT(j)  (256  + 64 * (j))
#define XB_XSUB(j)  (1280 + 64 * (j))
#define XB_XGEN(j)  (2304 + 64 * (j))
#define XB_TOP      3328
#define XB_TOPGEN   3392
#define XCD_BAR_WORDS 3456
#define XB_SPIN_CAP (1u << 18)
__device__ __forceinline__ unsigned xb_ld(unsigned* p)              { return __hip_atomic_load(p, __ATOMIC_RELAXED, __HIP_MEMORY_SCOPE_AGENT); }
__device__ __forceinline__ unsigned xb_add(unsigned* p, unsigned v) { return __hip_atomic_fetch_add(p, v, __ATOMIC_RELAXED, __HIP_MEMORY_SCOPE_AGENT); }
__device__ __forceinline__ unsigned xb_xcc_id() { return (unsigned)__builtin_amdgcn_s_getreg((3 << 11) | 20) & 0xFu; }
#define XB_SPIN(cond, bar) do { unsigned _sp = 0; while (cond) { __builtin_amdgcn_s_sleep(1); \
    if ((++_sp & 255u) == 0u) { if (xb_ld(&(bar)[XB_TMO])) break; if (_sp > XB_SPIN_CAP) { atomicAdd(&(bar)[XB_TMO], 1u); break; } } } } while (0)
struct XcdBarrier { unsigned* bar; unsigned x; volatile LAS unsigned* st; };
__device__ __forceinline__ XcdBarrier xcd_barrier_post(unsigned* bar, volatile LAS unsigned* st) {
    XcdBarrier b; b.bar = bar; b.x = xb_xcc_id(); b.st = st;
    if (threadIdx.x == 0) (void)xb_add(&bar[XB_XCNT(b.x)], 1u);
    return b;
}
__device__ __forceinline__ void xcd_barrier_complete(unsigned* bar, unsigned x, unsigned& nloc, unsigned& nx) {
    const unsigned G = gridDim.x * gridDim.y * gridDim.z;
    unsigned sum, cnt, mine, sp = 0u;
    for (;;) {
        sum = 0u; cnt = 0u; mine = 0u;
#pragma unroll
        for (unsigned j = 0; j < 16; ++j) { const unsigned c = xb_ld(&bar[XB_XCNT(j)]); sum += c; cnt += (c > 0u) ? 1u : 0u; mine = (j == x) ? c : mine; }
        if (sum == G) break;
        __builtin_amdgcn_s_sleep(1);
        if ((++sp & 255u) == 0u) { if (xb_ld(&bar[XB_TMO])) break; if (sp > XB_SPIN_CAP) { atomicAdd(&bar[XB_TMO], 1u); break; } }
    }
    nloc = mine > 0u ? mine : 1u; nx = cnt > 0u ? cnt : 1u;
}
__device__ __forceinline__ void xcd_barrier(const XcdBarrier& b) {
    asm volatile("s_waitcnt vmcnt(0)" ::: "memory");
    __syncthreads();
    if (threadIdx.x == 0) {
        unsigned* bar = b.bar;
        __builtin_amdgcn_s_waitcnt(0);
        unsigned nloc = b.st[0], nx = b.st[1];
        if (nloc == 0u) { xcd_barrier_complete(bar, b.x, nloc, nx); b.st[0] = nloc; b.st[1] = nx; }
        const unsigned old = xb_add(&bar[XB_XSUB(b.x)], 1u);
        const unsigned gen = old / nloc;
        if (old + 1u == (gen + 1u) * nloc) {
            __builtin_amdgcn_fence(__ATOMIC_RELEASE, "agent");
            asm volatile("s_waitcnt vmcnt(0)" ::: "memory");
            const unsigned og = xb_add(&bar[XB_TOP], 1u);
            const unsigned tg = og / nx;
            if (og + 1u == (tg + 1u) * nx) xb_add(&bar[XB_TOPGEN], 1u);
            else XB_SPIN(xb_ld(&bar[XB_TOPGEN]) == tg, bar);
            __builtin_amdgcn_fence(__ATOMIC_ACQUIRE, "agent");
            xb_add(&bar[XB_XGEN(b.x)], 1u);
            asm volatile("s_waitcnt vmcnt(0)" ::: "memory");
        } else {
            XB_SPIN(xb_ld(&bar[XB_XGEN(b.x)]) == gen, bar);
            __builtin_amdgcn_fence(__ATOMIC_ACQUIRE, "agent");
            asm volatile("s_waitcnt vmcnt(0)" ::: "memory");
        }
    }
    __syncthreads();
}

struct Frame {
    LAS unsigned char* lds;
    volatile LAS unsigned* MISC;
    gu32* ctl;
    int tid, lane, wave;
    int vcu, G;
    const float* x; float* out;
    const float *norm_g, *w_in, *w_out, *conv_a_w, *conv_a_b, *ln_a_g, *ln_a_b, *conv_b_w, *swa_sink, *na_rpb, *final_g;
    bf16 *Win_t, *Wout_t, *XN, *Y, *IB;
    f32x2* rope; float* ssqp;
};

__device__ __forceinline__ int opaque_tid() { int t = threadIdx.x; asm volatile("" : "+v"(t)); return t; }
__device__ __forceinline__ float wave_sum(float v) {
#pragma unroll
    for (int o = 1; o < 64; o <<= 1) v += __shfl_xor(v, o);
    return v;
}
__device__ __forceinline__ float wave_max(float v) {
#pragma unroll
    for (int o = 1; o < 64; o <<= 1) v = fmaxf(v, __shfl_xor(v, o));
    return v;
}

__host__ __device__ __forceinline__ int sigma32(int nb  ) {
    const int pn = nb >> 3, g = nb & 7, half = g >> 2, jj = (g & 3) * 32;
    switch (pn) {
        case 0: return (half ? 256 : 0) + jj;
        case 1: return (half ? 256 : 0) + 128 + jj;
        case 2: return (half ? 1280 : 1024) + jj;
        case 3: return (half ? 1280 : 1024) + 128 + jj;
        case 4: return (half ? 1536 : 768) + jj;
        case 5: return (half ? 1536 : 768) + 128 + jj;
        case 6: return 512 + g * 32;
        case 7: return 1792 + 64 * (g & 3) + (half ? 32 : 0);
        case 8: return (g & 3) < 2 ? 2048 + 64 * (g & 3) + (half ? 32 : 0)
                                   : 2176 + 64 * half + 32 * ((g & 3) - 2);
        case 9: return 2304 + g * 32;
        case 10: return 2560 + g * 32;
        case 11: return 2816 + g * 32;
        case 12: return 3072 + g * 32;
        default: return 3328 + g * 32;
    }
}

__device__ __forceinline__ void p0_transpose_item(const float* W, int K, int N, bf16* WT, int k0, int nrow0, int src_col0, const float* gain, LAS float* scr, int lane) {
#pragma unroll 8
    for (int i = 0; i < 32; ++i) { const int kk = 2 * i + (lane >> 5); float w = W[(size_t)(k0 + kk) * N + src_col0 + (lane & 31)]; if (gain) w *= gain[k0 + kk]; scr[kk * 33 + (lane & 31)] = w; }
    LDS_WAIT(); asm volatile("" ::: "memory");
    const int c = lane & 7;
#pragma unroll
    for (int j = 0; j < 4; ++j) { const int n = (lane >> 3) + 8 * j; const LAS float* s = scr + (8 * c) * 33 + n;
        v4u o; o.x = pk2(s[0 * 33], s[1 * 33]); o.y = pk2(s[2 * 33], s[3 * 33]); o.z = pk2(s[4 * 33], s[5 * 33]); o.w = pk2(s[6 * 33], s[7 * 33]);
        *(GAS v4u*)(WT + (size_t)(nrow0 + n) * K + k0 + 8 * c) = o; }
    LDS_WAIT(); asm volatile("" ::: "memory");
}
__device__ __forceinline__ void row_to_bf16_ssq(int lane, const float* xrow, bf16* orow, float* ssqp, int m) {
    const GAS f32x4* xr = (const GAS f32x4*)xrow + lane;
    f32x4 v[4]; float s = 0.f;
#pragma unroll
    for (int j = 0; j < 4; ++j) { v[j] = xr[64 * j]; s += (v[j].x * v[j].x + v[j].y * v[j].y) + (v[j].z * v[j].z + v[j].w * v[j].w); }
    s = wave_sum(s);
    if (lane < 4) ssqp[(size_t)lane * M + m] = lane == 0 ? s : 0.f;
    GAS unsigned long long* o8 = (GAS unsigned long long*)orow + lane;
#pragma unroll
    for (int j = 0; j < 4; ++j) o8[64 * j] = (unsigned long long)pk2(v[j].x, v[j].y) | ((unsigned long long)pk2(v[j].z, v[j].w) << 32);
}
__device__ __forceinline__ void rms_row_final(int lane, const float* xrow, float* orow, const float* g, const float* ssqp, int m) {
    const GAS f32x4* xr = (const GAS f32x4*)xrow + lane;
    f32x4 v[4];
#pragma unroll
    for (int j = 0; j < 4; ++j) v[j] = xr[64 * j];
    const float rstd = 1.0f / sqrtf(((ssqp[m] + ssqp[M + m]) + (ssqp[2 * M + m] + ssqp[3 * M + m])) * (1.f / D) + EPS);
    GAS f32x4* o = (GAS f32x4*)orow + lane;
#pragma unroll
    for (int j = 0; j < 4; ++j) { const f32x4 gg = ((const GAS f32x4*)g)[lane + 64 * j]; o[64 * j] = v[j] * rstd * gg; }
}

__device__ __forceinline__ void p0_prologue(Frame& F) {
    const int tid_ = opaque_tid(), lane_ = tid_ & 63, wave_ = __builtin_amdgcn_readfirstlane(tid_ >> 6);
    LAS float* scr = (LAS float*)(F.lds + RING_OFF + wave_ * 16384);
    const int gw = F.vcu * NWAVES + wave_, NGW = F.G * NWAVES;
    constexpr int I_IN = (D / 64) * (NIN / 32), I_OUT = (D / 64) * (D / 32);
    constexpr int NITEMS = DEPTH * (I_IN + I_OUT);
    for (int it = gw; it < NITEMS; it += NGW) {
        int r = it; const int l = r / (I_IN + I_OUT); r -= l * (I_IN + I_OUT);
        if (r < I_IN) { const int nblk = NIN / 32, kb = r / nblk, nb = r % nblk;
            p0_transpose_item(F.w_in + (size_t)l * D * NIN, D, NIN, F.Win_t + (size_t)l * NIN * D, 64 * kb, 32 * nb, sigma32(nb), F.norm_g + l * D, scr, lane_); }
        else { r -= I_IN; const int nblk = D / 32, kb = r / nblk, nb = r % nblk;
            p0_transpose_item(F.w_out + (size_t)l * D * D, D, D, F.Wout_t + (size_t)l * D * D, 64 * kb, 32 * nb, 32 * nb, nullptr, scr, lane_); }
    }
    for (int i = gw * 64 + lane_; i < SEQ * 32; i += NGW * 64) {
        const int pos = i >> 5, d = i & 31;
        const float inv_freq = exp2f(-(float)d * (13.287712379549449f / 32.0f));
        const float ang = (float)pos * inv_freq;
        const double a = (double)ang; const double k = rint(a * 0.15915494309189535); const double rr = a - k * 6.283185307179586476925;
        F.rope[i] = (f32x2){(float)cos(rr), (float)sin(rr)};
    }
    for (int m = gw; m < M; m += NGW) row_to_bf16_ssq(lane_, F.x + (size_t)m * D, F.XN + (size_t)m * D, F.ssqp, m);
}

struct EpiInProj {
    static constexpr bool PERM = true, AFTER_DRAIN = false;
    bf16* IB; const f32x2* rope; const float* ssqp;
    __device__ __forceinline__ static v4u pack8(const f32x4 a, const f32x4 b) { v4u w; w.x = pg8::cvt_pk_bf16(a[0], a[1]); w.y = pg8::cvt_pk_bf16(a[2], a[3]); w.z = pg8::cvt_pk_bf16(b[0], b[1]); w.w = pg8::cvt_pk_bf16(b[2], b[3]); return w; }
    __device__ __forceinline__ void operator()(const f32x4 (&acc)[2][2][4][2], const pg8::Unit& u, int wr, int wc, int fr, int fq) const {
        const int pn = u.pn, row0 = u.pm * 256 + wr * 64 + fr, cl = wc * 32 + 8 * fq;
        float rs[2][4];
#pragma unroll
        for (int ai = 0; ai < 2; ++ai)
#pragma unroll
            for (int m = 0; m < 4; ++m) { const float* sp = ssqp + row0 + ai * 128 + m * 16; rs[ai][m] = 1.0f / sqrtf(((sp[0] + sp[M]) + (sp[2 * M] + sp[3 * M])) * (1.f / D) + EPS); }
        if (pn < 6) {
            bf16* O = IB + (size_t)(pn < 2 ? IB_H : pn < 4 ? IB_CX : IB_GB) * IB_ELEMS + 128 * (pn & 1) + cl;
#pragma unroll
            for (int ai = 0; ai < 2; ++ai)
#pragma unroll
                for (int m = 0; m < 4; ++m) {
                    f32x4 o[2];
#pragma unroll
                    for (int n = 0; n < 2; ++n) { const f32x4 a = acc[ai][0][m][n] * rs[ai][m], b = acc[ai][1][m][n] * rs[ai][m];
#pragma unroll
                        for (int i = 0; i < 4; ++i) o[n][i] = pn < 2 ? a[i] * sigmoidf_(b[i]) : pn < 4 ? a[i] * b[i] : a[i] * siluf_(b[i]); }
                    *(v4u*)(O + (size_t)(row0 + ai * 128 + m * 16) * 256) = pack8(o[0], o[1]);
                }
        } else if (pn == 7) {
            bf16* O = IB + (size_t)IB_CQ * IB_ELEMS + 64 * wc + 8 * fq;
#pragma unroll
            for (int ai = 0; ai < 2; ++ai)
#pragma unroll
                for (int m = 0; m < 4; ++m) { const int row = row0 + ai * 128 + m * 16; const f32x4* rp = (const f32x4*)(rope + (size_t)(row & (SEQ - 1)) * 32 + 8 * fq);
                    f32x4 o1[2], o2[2];
#pragma unroll
                    for (int n = 0; n < 2; ++n) { const f32x4 cs0 = rp[2 * n], cs1 = rp[2 * n + 1]; const f32x4 x1 = acc[ai][0][m][n] * (QSCALE * rs[ai][m]), x2 = acc[ai][1][m][n] * (QSCALE * rs[ai][m]);
                        o1[n][0] = x1[0] * cs0[0] - x2[0] * cs0[1]; o2[n][0] = x2[0] * cs0[0] + x1[0] * cs0[1];
                        o1[n][1] = x1[1] * cs0[2] - x2[1] * cs0[3]; o2[n][1] = x2[1] * cs0[2] + x1[1] * cs0[3];
                        o1[n][2] = x1[2] * cs1[0] - x2[2] * cs1[1]; o2[n][2] = x2[2] * cs1[0] + x1[2] * cs1[1];
                        o1[n][3] = x1[3] * cs1[2] - x2[3] * cs1[3]; o2[n][3] = x2[3] * cs1[2] + x1[3] * cs1[3]; }
                    *(v4u*)(O + (size_t)row * 256) = pack8(o1[0], o1[1]); *(v4u*)(O + (size_t)row * 256 + 32) = pack8(o2[0], o2[1]);
                    asm volatile("" ::: "memory"); }
        } else if (pn == 8) {
            if (wc < 2) {
                bf16* O = IB + (size_t)IB_CKV * IB_ELEMS + 64 * wc + 8 * fq;
#pragma unroll
                for (int ai = 0; ai < 2; ++ai)
#pragma unroll
                    for (int m = 0; m < 4; ++m) { const int row = row0 + ai * 128 + m * 16; const f32x4* rp = (const f32x4*)(rope + (size_t)(row & (SEQ - 1)) * 32 + 8 * fq);
                        f32x4 o1[2], o2[2];
#pragma unroll
                        for (int n = 0; n < 2; ++n) { const f32x4 cs0 = rp[2 * n], cs1 = rp[2 * n + 1]; const f32x4 x1 = acc[ai][0][m][n] * rs[ai][m], x2 = acc[ai][1][m][n] * rs[ai][m];
                            o1[n][0] = x1[0] * cs0[0] - x2[0] * cs0[1]; o2[n][0] = x2[0] * cs0[0] + x1[0] * cs0[1];
                            o1[n][1] = x1[1] * cs0[2] - x2[1] * cs0[3]; o2[n][1] = x2[1] * cs0[2] + x1[1] * cs0[3];
                            o1[n][2] = x1[2] * cs1[0] - x2[2] * cs1[1]; o2[n][2] = x2[2] * cs1[0] + x1[2] * cs1[1];
                            o1[n][3] = x1[3] * cs1[2] - x2[3] * cs1[3]; o2[n][3] = x2[3] * cs1[2] + x1[3] * cs1[3]; }
                        *(v4u*)(O + (size_t)row * 256) = pack8(o1[0], o1[1]); *(v4u*)(O + (size_t)row * 256 + 32) = pack8(o2[0], o2[1]);
                        asm volatile("" ::: "memory"); }
            } else {
                bf16* O = IB + (size_t)IB_CKV * IB_ELEMS + 128 + 32 * (wc - 2) + 8 * fq;
#pragma unroll
                for (int ai = 0; ai < 2; ++ai)
#pragma unroll
                    for (int m = 0; m < 4; ++m) { const int row = row0 + ai * 128 + m * 16;
#pragma unroll
                        for (int bj = 0; bj < 2; ++bj) *(v4u*)(O + (size_t)row * 256 + 64 * bj) = pack8(acc[ai][bj][m][0] * rs[ai][m], acc[ai][bj][m][1] * rs[ai][m]); }
            }
        } else {
            const int ib = pn == 6 ? IB_AZ : pn == 9 ? IB_CZ : pn == 10 ? IB_DQ : pn == 11 ? IB_DK : pn == 12 ? IB_DV : IB_DZ;
            const int mode = (pn == 6 || pn == 9 || pn == 13) ? 1 : (pn == 10 ? 2 : 0);
            bf16* O = IB + (size_t)ib * IB_ELEMS + cl;
#pragma unroll
            for (int ai = 0; ai < 2; ++ai)
#pragma unroll
                for (int m = 0; m < 4; ++m) { const int row = row0 + ai * 128 + m * 16;
#pragma unroll
                    for (int bj = 0; bj < 2; ++bj) { f32x4 v[2];
#pragma unroll
                        for (int n = 0; n < 2; ++n) { v[n] = acc[ai][bj][m][n] * rs[ai][m];
                            if (mode == 1) {
#pragma unroll
                                for (int i = 0; i < 4; ++i) v[n][i] = siluf_(v[n][i]); }
                            else if (mode == 2) v[n] = v[n] * QSCALE; }
                        *(v4u*)(O + (size_t)row * 256 + 128 * bj) = pack8(v[0], v[1]); } }
        }
    }
};
struct EpiOutProj {
    static constexpr bool PERM = true, AFTER_DRAIN = true;
    const float* base; float* out; bf16* xn; float* ssqp;
    __device__ __forceinline__ void fused(f32x4 (&acc)[2][2][4][2], const pg8::Unit& u, int wr, int wc, int fr, int fq, LAS unsigned char* lds, int wid, int lane) const {
        const int row0 = u.pm * 256 + wr * 64 + fr, col0 = u.pn * 256 + wc * 32 + 8 * fq;
        LAS float* P = (LAS float*)lds;
#pragma unroll
        for (int ai = 0; ai < 2; ++ai)
#pragma unroll
            for (int m = 0; m < 4; ++m) { const size_t off = (size_t)(row0 + ai * 128 + m * 16) * D + col0; float q = 0.f;
#pragma unroll
                for (int bj = 0; bj < 2; ++bj) { const f32x4 v0 = *(const f32x4*)(base + off + bj * 128) + acc[ai][bj][m][0], v1 = *(const f32x4*)(base + off + bj * 128 + 4) + acc[ai][bj][m][1];
                    *(f32x4*)(out + off + bj * 128) = v0; *(f32x4*)(out + off + bj * 128 + 4) = v1;
                    q += ((v0[0] * v0[0] + v0[1] * v0[1]) + (v0[2] * v0[2] + v0[3] * v0[3])) + ((v1[0] * v1[0] + v1[1] * v1[1]) + (v1[2] * v1[2] + v1[3] * v1[3]));
                    if (xn) *(v4u*)(xn + off + bj * 128) = EpiInProj::pack8(v0, v1); }
                q += __shfl_xor(q, 16); q += __shfl_xor(q, 32);
                if (fq == 0) P[(ai * 128 + wr * 64 + m * 16 + fr) * 4 + wc] = q;
                if (m & 1) asm volatile("" ::: "memory"); }
        asm volatile("s_waitcnt lgkmcnt(0)" ::: "memory"); __builtin_amdgcn_s_barrier(); asm volatile("" ::: "memory");
        const int t = wid * 64 + lane;
        if (t < 256) { const f32x4 p = *(const LAS f32x4*)(P + 4 * t); ssqp[(size_t)u.pn * M + u.pm * 256 + t] = (p[0] + p[1]) + (p[2] + p[3]); }
    }
};

__device__ __forceinline__ void mixer_a(Frame& F, int layer) {
    LAS unsigned char* lds = F.lds;
    const bf16* H = F.IB + (size_t)IB_H * IB_ELEMS; const bf16* AZ = F.IB + (size_t)IB_AZ * IB_ELEMS;
    const float* cw = F.conv_a_w + layer * 31 * 256; const float* cb = F.conv_a_b + layer * 256; const float* lg = F.ln_a_g + layer * 256; const float* lb = F.ln_a_b + layer * 256;
    const int tid_ = opaque_tid(), lane_ = tid_ & 63, wave_ = __builtin_amdgcn_readfirstlane(tid_ >> 6);
    const int cp = tid_ & 127, tq = tid_ >> 7;
    for (int u = F.vcu; u < M / 64; u += F.G) {
        const int t0 = u * 64, s0 = t0 & (SEQ - 1), bbase = t0 - s0;
        { v4u tv[6];
#pragma unroll
            for (int it = 0; it < 6; ++it) { const int c = tid_ + 512 * it, i = c >> 5, ch = c & 31, s = s0 - 15 + i; tv[it] = (v4u){0u, 0u, 0u, 0u};
                if (i < 94 && s >= 0 && s < SEQ) tv[it] = *(const GAS v4u*)(H + (size_t)(bbase + s) * 256 + ch * 8); }
#pragma unroll
            for (int it = 0; it < 6; ++it) { const int c = tid_ + 512 * it, i = c >> 5, ch = c & 31; if (i < 94) *(LAS v4u*)(lds + i * 512 + ch * 16) = tv[it]; } }
        __syncthreads();
        {
            float w0[31], w1[31];
#pragma unroll
            for (int j = 0; j < 31; ++j) { const f32x2 w = *(const GAS f32x2*)(cw + j * 256 + 2 * cp); w0[j] = w.x; w1[j] = w.y; }
            const f32x2 bb = *(const GAS f32x2*)(cb + 2 * cp);
            float a0[16], a1[16];
#pragma unroll
            for (int o = 0; o < 16; ++o) { a0[o] = bb.x; a1[o] = bb.y; }
#pragma unroll
            for (int i = 0; i < 46; ++i) { const unsigned hv = *(const LAS unsigned*)(lds + (tq * 16 + i) * 512 + cp * 4); const float h0 = bflo(hv), h1 = bfhi(hv);
#pragma unroll
                for (int o = 0; o < 16; ++o) { const int j = i - o; if (j >= 0 && j <= 30) { a0[o] += w0[j] * h0; a1[o] += w1[j] * h1; } } }
#pragma unroll
            for (int o = 0; o < 16; ++o) *(LAS f32x2*)(lds + 49152 + ((tq * 16 + o) * 256 + 2 * cp) * 4) = (f32x2){a0[o], a1[o]};
        }
        __syncthreads();
        {
            const f32x4 g4 = *(const GAS f32x4*)(lg + 4 * lane_), b4 = *(const GAS f32x4*)(lb + 4 * lane_);
            f32x4 xv[8]; v2u az[8]; float sm[8];
#pragma unroll
            for (int k = 0; k < 8; ++k) { const int tok = 8 * wave_ + k; xv[k] = *(const LAS f32x4*)(lds + 49152 + (tok * 256 + 4 * lane_) * 4);
                az[k] = *(const GAS v2u*)(AZ + (size_t)(t0 + tok) * 256 + 4 * lane_); sm[k] = (xv[k].x + xv[k].y) + (xv[k].z + xv[k].w); }
#pragma unroll
            for (int o = 1; o < 64; o <<= 1)
#pragma unroll
                for (int k = 0; k < 8; ++k) sm[k] += __shfl_xor(sm[k], o);
#pragma unroll
            for (int k = 0; k < 8; ++k) { xv[k] = xv[k] - sm[k] * (1.f / 256.f); sm[k] = (xv[k].x * xv[k].x + xv[k].y * xv[k].y) + (xv[k].z * xv[k].z + xv[k].w * xv[k].w); }
#pragma unroll
            for (int o = 1; o < 64; o <<= 1)
#pragma unroll
                for (int k = 0; k < 8; ++k) sm[k] += __shfl_xor(sm[k], o);
#pragma unroll
            for (int k = 0; k < 8; ++k) { const int tok = 8 * wave_ + k; const float rstd = 1.0f / sqrtf(sm[k] * (1.f / 256.f) + EPS);
                const f32x4 y = xv[k] * rstd * g4 + b4;
                v2u o; o.x = pk2(siluf_(y.x) * bflo(az[k].x), siluf_(y.y) * bfhi(az[k].x)); o.y = pk2(siluf_(y.z) * bflo(az[k].y), siluf_(y.w) * bfhi(az[k].y));
                *(GAS v2u*)(F.Y + (size_t)(t0 + tok) * D + 4 * lane_) = o; }
        }
        __syncthreads();
    }
}
__device__ __forceinline__ void mixer_b(Frame& F, int layer) {
    const bf16* CX = F.IB + (size_t)IB_CX * IB_ELEMS; const bf16* GB = F.IB + (size_t)IB_GB * IB_ELEMS; const float* w = F.conv_b_w + layer * 3 * 256;
    const int tid_ = opaque_tid(), ch = (tid_ & 31) * 8;
    f32x4 wv[3][2];
#pragma unroll
    for (int j = 0; j < 3; ++j) { wv[j][0] = *(const GAS f32x4*)(w + j * 256 + ch); wv[j][1] = *(const GAS f32x4*)(w + j * 256 + ch + 4); }
    constexpr int NIT = (M * 32) / (256 * 512);
    for (int base = F.vcu * 512 + tid_; base < M * 32; base += F.G * 512 * NIT) {
        v4u xm[NIT], x0[NIT], xp[NIT], gb[NIT];
#pragma unroll
        for (int k = 0; k < NIT; ++k) { const int it = base + k * F.G * 512, t = it >> 5, s = t & (SEQ - 1); const v4u z = (v4u){0u, 0u, 0u, 0u};
            if (it < M * 32) { xm[k] = s > 0 ? *(const GAS v4u*)(CX + (size_t)(t - 1) * 256 + ch) : z; x0[k] = *(const GAS v4u*)(CX + (size_t)t * 256 + ch);
                xp[k] = s < SEQ - 1 ? *(const GAS v4u*)(CX + (size_t)(t + 1) * 256 + ch) : z; gb[k] = *(const GAS v4u*)(GB + (size_t)t * 256 + ch); } }
#pragma unroll
        for (int k = 0; k < NIT; ++k) { const int it = base + k * F.G * 512, t = it >> 5;
            if (it < M * 32) { v4u o;
#pragma unroll
                for (int q = 0; q < 4; ++q) { const int e = (2 * q) & 3, hv = (2 * q) >> 2;
                    const float r0 = wv[0][hv][e] * bflo(xm[k][q]) + wv[1][hv][e] * bflo(x0[k][q]) + wv[2][hv][e] * bflo(xp[k][q]);
                    const float r1 = wv[0][hv][e + 1] * bfhi(xm[k][q]) + wv[1][hv][e + 1] * bfhi(x0[k][q]) + wv[2][hv][e + 1] * bfhi(xp[k][q]);
                    o[q] = pk2(bflo(gb[k][q]) * r0, bfhi(gb[k][q]) * r1); }
                *(GAS v4u*)(F.Y + (size_t)t * D + 256 + ch) = o; } }
    }
}
typedef short v4i16_t __attribute__((ext_vector_type(4)));
constexpr int ATT_PITCH = 144;
struct AttnState { float m, l; f32x4 negm; f32x4 o[4]; };
constexpr float ATT_THR = 8.0f;
__device__ __forceinline__ bf16x8 vtr2(const LAS unsigned char* p) {
    const v4i16_t lo = __builtin_amdgcn_ds_read_tr16_b64_v4i16((LAS v4i16_t*)p), hi = __builtin_amdgcn_ds_read_tr16_b64_v4i16((LAS v4i16_t*)(p + 16 * ATT_PITCH));
    return (bf16x8){lo[0], lo[1], lo[2], lo[3], hi[0], hi[1], hi[2], hi[3]};
}
__device__ __forceinline__ void attn_init(AttnState& st, float m0, float l0) {
    st.m = m0; st.l = l0; st.negm = (f32x4){-m0, -m0, -m0, -m0};
#pragma unroll
    for (int dt = 0; dt < 4; ++dt) st.o[dt] = (f32x4){0.f, 0.f, 0.f, 0.f};
}
template <bool FIRST>
__device__ __forceinline__ void attn_step(AttnState& st, f32x4 s0, f32x4 s1, const bf16x8 (&vf)[4]) {
    float mx = fmaxf(fmaxf(fmaxf(s0[0], s0[1]), fmaxf(s0[2], s0[3])), fmaxf(fmaxf(s1[0], s1[1]), fmaxf(s1[2], s1[3])));
    if (FIRST || __any(mx > ATT_THR)) {
        mx = fmaxf(mx, __shfl_xor(mx, 16)); mx = fmaxf(mx, __shfl_xor(mx, 32));
        const float d = FIRST ? mx : fmaxf(mx, 0.f);
        if (!FIRST) { const float a = __builtin_amdgcn_exp2f(-d); st.l *= a;
#pragma unroll
            for (int dt = 0; dt < 4; ++dt) st.o[dt] = st.o[dt] * a; }
        st.m += d; st.negm = (f32x4){-st.m, -st.m, -st.m, -st.m}; s0 = s0 - d; s1 = s1 - d;
    }
    f32x4 p0, p1;
#pragma unroll
    for (int r = 0; r < 4; ++r) { p0[r] = __builtin_amdgcn_exp2f(s0[r]); p1[r] = __builtin_amdgcn_exp2f(s1[r]); }
    st.l += ((p0[0] + p0[1]) + (p0[2] + p0[3])) + ((p1[0] + p1[1]) + (p1[2] + p1[3]));
    v4u pw; pw.x = pg8::cvt_pk_bf16(p0[0], p0[1]); pw.y = pg8::cvt_pk_bf16(p0[2], p0[3]); pw.z = pg8::cvt_pk_bf16(p1[0], p1[1]); pw.w = pg8::cvt_pk_bf16(p1[2], p1[3]);
    const bf16x8 pf = __builtin_bit_cast(bf16x8, pw);
#pragma unroll
    for (int dt = 0; dt < 4; ++dt) st.o[dt] = __builtin_amdgcn_mfma_f32_16x16x32_bf16(vf[dt], pf, st.o[dt], 0, 0, 0);
}
__device__ __forceinline__ void attn_finish(const AttnState& st, const bf16* gate_row, bf16* out_row, int g) {
    float l = st.l; l += __shfl_xor(l, 16); l += __shfl_xor(l, 32); const float inv = 1.0f / l;
#pragma unroll
    for (int dt = 0; dt < 4; ++dt) { const v2u gz = *(const GAS v2u*)(gate_row + 16 * dt + 4 * g); const f32x4 o = st.o[dt] * inv;
        v2u w; w.x = pk2(o[0] * bflo(gz.x), o[1] * bfhi(gz.x)); w.y = pk2(o[2] * bflo(gz.y), o[3] * bfhi(gz.y));
        *(GAS v2u*)(out_row + 16 * dt + 4 * g) = w; }
}
#define MFMA16(a, b, c) __builtin_amdgcn_mfma_f32_16x16x32_bf16(a, b, c, 0, 0, 0)
__device__ __forceinline__ void mixer_c(Frame& F, int layer) {
    const bf16* CQ = F.IB + (size_t)IB_CQ * IB_ELEMS; const bf16* CKV = F.IB + (size_t)IB_CKV * IB_ELEMS; const bf16* CZ = F.IB + (size_t)IB_CZ * IB_ELEMS;
    const int tid_ = opaque_tid(), lane = tid_ & 63, wave_ = __builtin_amdgcn_readfirstlane(tid_ >> 6), g = lane >> 4, li = lane & 15;
    LAS unsigned char* Kl = F.lds; LAS unsigned char* Vl = F.lds + 384 * ATT_PITCH;
    for (int u = F.vcu; u < NB * 32 * 2; u += F.G) {
        const int kvh = u & 1, n = (u >> 1) & 31, b = u >> 6;
        const int tq0 = b * SEQ + n * 128, tk0 = tq0 - 128, kk_lo = n == 0 ? 128 : 0, kk_hi = n == 31 ? 255 : 383;
        __syncthreads();
        { v4u tk[6], tv[6];
#pragma unroll
            for (int it = 0; it < 6; ++it) { const int c = tid_ + 512 * it, row = c >> 3, ch = c & 7; int tok = tk0 + row; tok = tok < b * SEQ ? b * SEQ : (tok > b * SEQ + SEQ - 1 ? b * SEQ + SEQ - 1 : tok);
                const bf16* src = CKV + (size_t)tok * 256 + 64 * kvh + 8 * ch; tk[it] = *(const GAS v4u*)src; tv[it] = *(const GAS v4u*)(src + 128); }
#pragma unroll
            for (int it = 0; it < 6; ++it) { const int c = tid_ + 512 * it, row = c >> 3, ch = c & 7; *(LAS v4u*)(Kl + row * ATT_PITCH + ch * 16) = tk[it]; *(LAS v4u*)(Vl + row * ATT_PITCH + ch * 16) = tv[it]; } }
        const int hq = 2 * kvh + (wave_ >> 2), wq = wave_ & 3;
        bf16x8 qf[2][2];
#pragma unroll
        for (int qt = 0; qt < 2; ++qt)
#pragma unroll
            for (int ks = 0; ks < 2; ++ks) qf[qt][ks] = *(const GAS bf16x8*)(CQ + (size_t)(tq0 + 32 * wq + 16 * qt + li) * 256 + 64 * hq + 32 * ks + 8 * g);
        const float sink = F.swa_sink[layer * 4 + hq] * LOG2E;
        AttnState st[2];
        attn_init(st[0], sink, g == 0 ? 1.0f : 0.0f); attn_init(st[1], sink, g == 0 ? 1.0f : 0.0f);
        __syncthreads();
#pragma unroll 1
        for (int s = 0; s < 9; ++s) { const int kb = 32 * wq + 32 * s; if (kb < kk_lo || kb > kk_hi) continue;
            bf16x8 kf[2][2], vf[4];
#pragma unroll
            for (int kt = 0; kt < 2; ++kt)
#pragma unroll
                for (int ks = 0; ks < 2; ++ks) kf[kt][ks] = *(const LAS bf16x8*)(Kl + (kb + 16 * kt + li) * ATT_PITCH + (32 * ks + 8 * g) * 2);
#pragma unroll
            for (int dt = 0; dt < 4; ++dt) vf[dt] = vtr2(Vl + (kb + 4 * g + (li >> 2)) * ATT_PITCH + (16 * dt + 4 * (li & 3)) * 2);
#pragma unroll
            for (int qt = 0; qt < 2; ++qt) {
                f32x4 s0 = MFMA16(kf[0][0], qf[qt][0], st[qt].negm); s0 = MFMA16(kf[0][1], qf[qt][1], s0);
                f32x4 s1 = MFMA16(kf[1][0], qf[qt][0], st[qt].negm); s1 = MFMA16(kf[1][1], qf[qt][1], s1);
                if (s == 0 || s == 8) { const int qrel = 16 * qt + li;
#pragma unroll
                    for (int r = 0; r < 4; ++r) { const int k0 = 4 * g + r, k1 = 16 + 4 * g + r;
                        const bool v0 = s == 0 ? k0 >= qrel : k0 <= qrel, v1 = s == 0 ? k1 >= qrel : k1 <= qrel;
                        s0[r] = v0 ? s0[r] : -INFINITY; s1[r] = v1 ? s1[r] : -INFINITY; } }
                attn_step<false>(st[qt], s0, s1, vf); }
        }
#pragma unroll
        for (int qt = 0; qt < 2; ++qt) { const size_t tok = (size_t)(tq0 + 32 * wq + 16 * qt + li);
            attn_finish(st[qt], CZ + tok * 256 + 64 * hq, F.Y + tok * D + 512 + 64 * hq, g); }
    }
}
constexpr int NA_BIAS_OFF = 11 * 64 * ATT_PITCH;
template <bool F0, bool F1, bool A0, bool A1>
__device__ __forceinline__ void na_step(AttnState& st0, AttnState& st1, const bf16x8 (&kf)[2][2], const bf16x8 (&qf)[2][2], const bf16x8 (&vf)[4], const LAS float* brow0, const LAS float* brow1, int g, int lo) {
    float bz0[4], bz1[4], by0[4], by1[4];
#pragma unroll
    for (int q = 0; q < 4; ++q) { if (A0) { bz0[q] = brow0[4 * g + q]; bz1[q] = brow0[16 + 4 * g + q]; } if (A1) { by0[q] = brow1[4 * g + q]; by1[q] = brow1[16 + 4 * g + q]; } }
    if (A0) { f32x4 s0 = MFMA16(kf[0][0], qf[0][0], st0.negm); s0 = MFMA16(kf[0][1], qf[0][1], s0); f32x4 s1 = MFMA16(kf[1][0], qf[0][0], st0.negm); s1 = MFMA16(kf[1][1], qf[0][1], s1);
#pragma unroll
        for (int q = 0; q < 4; ++q) { const int k0 = 4 * g + q, k1 = 16 + 4 * g + q;
            s0[q] = (k0 >= lo && k0 <= lo + 15) ? s0[q] + bz0[q] : -INFINITY; s1[q] = (k1 >= lo && k1 <= lo + 15) ? s1[q] + bz1[q] : -INFINITY; }
        attn_step<F0>(st0, s0, s1, vf); }
    if (A1) { f32x4 s0 = MFMA16(kf[0][0], qf[1][0], st1.negm); s0 = MFMA16(kf[0][1], qf[1][1], s0); f32x4 s1 = MFMA16(kf[1][0], qf[1][0], st1.negm); s1 = MFMA16(kf[1][1], qf[1][1], s1);
#pragma unroll
        for (int q = 0; q < 4; ++q) { const int k0 = 4 * g + q, k1 = 16 + 4 * g + q;
            s0[q] = (k0 >= lo && k0 <= lo + 15) ? s0[q] + by0[q] : -INFINITY; s1[q] = (k1 >= lo && k1 <= lo + 15) ? s1[q] + by1[q] : -INFINITY; }
        attn_step<F1>(st1, s0, s1, vf); }
}
__device__ __forceinline__ void mixer_d(Frame& F, int layer) {
    const bf16* DQ = F.IB + (size_t)IB_DQ * IB_ELEMS; const bf16* DK = F.IB + (size_t)IB_DK * IB_ELEMS; const bf16* DV = F.IB + (size_t)IB_DV * IB_ELEMS; const bf16* DZ = F.IB + (size_t)IB_DZ * IB_ELEMS;
    const int tid_ = opaque_tid(), lane = tid_ & 63, wave_ = __builtin_amdgcn_readfirstlane(tid_ >> 6), g = lane >> 4, li = lane & 15;
    LAS unsigned char* Vl = F.lds; LAS float* bias = (LAS float*)(F.lds + NA_BIAS_OFF);
    for (int u = F.vcu; u < NB * 4 * 16; u += F.G) {
        const int rq = u & 15, h = (u >> 4) & 3, b = u >> 6, ra = 4 * rq;
        const int lo_row = ra - 4 < 0 ? 0 : (ra - 4 > 56 ? 56 : ra - 4), hi_r0 = ra - 1 > 56 ? 56 : ra - 1  ;
        const int hi_row = (hi_r0 < 0 ? 0 : hi_r0) + 7, nrows = hi_row - lo_row + 1;
        const size_t tb = (size_t)b * SEQ;
        __syncthreads();
        { v4u tv[11];
#pragma unroll
            for (int it = 0; it < 11; ++it) { const int gr = lo_row + it > 63 ? 63 : lo_row + it; tv[it] = *(const GAS v4u*)(DV + (tb + gr * 64 + (tid_ >> 3)) * 256 + 64 * h + 8 * (tid_ & 7)); }
#pragma unroll
            for (int it = 0; it < 11; ++it) *(LAS v4u*)(Vl + (it * 64 + (tid_ >> 3)) * ATT_PITCH + (tid_ & 7) * 16) = tv[it]; }
        for (int c = tid_; c < 544; c += 512) { const int e = c - 32; bias[c] = (e >= 0 && e < 465) ? F.na_rpb[(size_t)(layer * 4 + h) * 465 + e] * LOG2E : 0.f; }
        const int rpw = wave_ >> 2, qg = wave_ & 3, rA = ra + 2 * rpw, rB = rA + 1;
        const int r0A = rA - 4 < 0 ? 0 : (rA - 4 > 56 ? 56 : rA - 4), r0B = rB - 4 < 0 ? 0 : (rB - 4 > 56 ? 56 : rB - 4), dB = r0B - r0A;
        const int wc0 = qg == 0 ? 0 : qg == 1 ? 8 : qg == 2 ? 24 : 32;
        const int c = 16 * qg + li, c0 = c - 8 < 0 ? 0 : (c - 8 > 48 ? 48 : c - 8), lo = c0 - wc0;
        const size_t tokA = tb + rA * 64 + c, tokB = tokA + 64;
        bf16x8 qf[2][2];
#pragma unroll
        for (int ks = 0; ks < 2; ++ks) { qf[0][ks] = *(const GAS bf16x8*)(DQ + tokA * 256 + 64 * h + 32 * ks + 8 * g); qf[1][ks] = *(const GAS bf16x8*)(DQ + tokB * 256 + 64 * h + 32 * ks + 8 * g); }
        AttnState stA, stB; attn_init(stA, 0.f, 0.f); attn_init(stB, 0.f, 0.f);
        const bf16* kbase = DK + (tb + wc0 + li) * 256 + 64 * h + 8 * g;
        bf16x8 kfr[2][2][2];
#define NA_KLOAD(slot, j) do { const int kr_ = (r0A + (j)) > 63 ? 63 : (r0A + (j)); _Pragma("unroll") for (int kt = 0; kt < 2; ++kt) _Pragma("unroll") for (int ks = 0; ks < 2; ++ks) \
            kfr[slot][kt][ks] = *(const GAS bf16x8*)(kbase + (size_t)(kr_ * 64 + 16 * kt) * 256 + 32 * ks); } while (0)
        NA_KLOAD(0, 0); NA_KLOAD(1, 1);
        __syncthreads();
        const LAS float* bcol = bias + 32 + (wc0 - c + 15);
        const LAS unsigned char* vbase = Vl + ((r0A - lo_row) * 64 + wc0 + 4 * g + (li >> 2)) * ATT_PITCH + (4 * (li & 3)) * 2;
#define NA_STEP(j, F0, F1, A0, A1) do { bf16x8 vf[4]; _Pragma("unroll") for (int dt = 0; dt < 4; ++dt) vf[dt] = vtr2(vbase + (j) * 64 * ATT_PITCH + 32 * dt); \
            na_step<F0, F1, A0, A1>(stA, stB, kfr[(j) & 1], qf, vf, bcol + (r0A + (j) - rA + 7) * 31, bcol + (r0A + (j) - rB + 7) * 31, g, lo); } while (0)
        if (dB == 0) {
            NA_STEP(0, true, true, true, true);   NA_KLOAD(0, 2);
            NA_STEP(1, false, false, true, true); NA_KLOAD(1, 3);
            NA_STEP(2, false, false, true, true); NA_KLOAD(0, 4);
            NA_STEP(3, false, false, true, true); NA_KLOAD(1, 5);
            NA_STEP(4, false, false, true, true); NA_KLOAD(0, 6);
            NA_STEP(5, false, false, true, true); NA_KLOAD(1, 7);
            NA_STEP(6, false, false, true, true);
            NA_STEP(7, false, false, true, true);
        } else {
            NA_STEP(0, true, false, true, false); NA_KLOAD(0, 2);
            NA_STEP(1, false, true, true, true);  NA_KLOAD(1, 3);
            NA_STEP(2, false, false, true, true); NA_KLOAD(0, 4);
            NA_STEP(3, false, false, true, true); NA_KLOAD(1, 5);
            NA_STEP(4, false, false, true, true); NA_KLOAD(0, 6);
            NA_STEP(5, false, false, true, true); NA_KLOAD(1, 7);
            NA_STEP(6, false, false, true, true); NA_KLOAD(0, 8);
            NA_STEP(7, false, false, true, true);
            NA_STEP(8, false, false, false, true);
        }
#undef NA_STEP
#undef NA_KLOAD
        attn_finish(stA, DZ + tokA * 256 + 64 * h, F.Y + tokA * D + 768 + 64 * h, g);
        attn_finish(stB, DZ + tokB * 256 + 64 * h, F.Y + tokB * D + 768 + 64 * h, g);
    }
}

struct Args { const float* in[12]; float* out; unsigned char* ws; int ph_lo, ph_hi, li, pad; };
__global__ void __launch_bounds__(NWAVES * 64, 2) hymba_fwd(Args args) {
    extern __shared__ __attribute__((aligned(16))) unsigned char lds[];
    Frame F;
    F.lds = (LAS unsigned char*)lds;
    F.MISC = (volatile LAS unsigned*)(F.lds + MISC_OFF);
    F.tid = threadIdx.x; F.lane = F.tid & 63; F.wave = __builtin_amdgcn_readfirstlane(F.tid >> 6);
    F.G = gridDim.x; { const int bx = blockIdx.x; F.vcu = (F.G % 8 == 0) ? (bx % 8) * (F.G / 8) + bx / 8 : bx; }
    unsigned char* ws = args.ws;
    F.ctl = (gu32*)(ws + WS_CTL);
    F.x = args.in[0]; F.norm_g = args.in[1]; F.w_in = args.in[2]; F.w_out = args.in[3]; F.conv_a_w = args.in[4]; F.conv_a_b = args.in[5]; F.ln_a_g = args.in[6]; F.ln_a_b = args.in[7];
    F.conv_b_w = args.in[8]; F.swa_sink = args.in[9]; F.na_rpb = args.in[10]; F.final_g = args.in[11]; F.out = args.out;
    F.Win_t = (bf16*)(ws + WS_WIN); F.Wout_t = (bf16*)(ws + WS_WOUT); F.XN = (bf16*)(ws + WS_XN); F.Y = (bf16*)(ws + WS_Y); F.IB = (bf16*)(ws + WS_I); F.rope = (f32x2*)(ws + WS_ROPE); F.ssqp = (float*)(ws + WS_SSQ);
    for (int u = F.tid; u < (LDS_BYTES - LDSCTL_OFF) / 4; u += NWAVES * 64) ((LAS unsigned*)(F.lds + LDSCTL_OFF))[u] = 0u;
    __syncthreads();
    XcdBarrier bar; bar.bar = (unsigned*)(F.ctl + CW_BAR); bar.x = 0; bar.st = nullptr;
    if (N_LAUNCHES == 1) bar = xcd_barrier_post((unsigned*)(F.ctl + CW_BAR), F.MISC + 8);
#define GRID_BAR() do { if (N_LAUNCHES == 1) xcd_barrier(bar); } while (0)
    const int lo = args.ph_lo, hi = args.ph_hi;
#define IN(k) (lo <= (k) && (k) < hi)
#define BOTH(k) (IN(k) && IN((k) + 1))

    if (IN(0)) { p0_prologue(F); if (BOTH(0)) GRID_BAR(); }
#pragma unroll 1
    for (int l = 0; l < DEPTH; ++l) {
        const int pb = 1 + 4 * l;
        if (IN(pb)) {
            pg8::Gemm g{F.XN, F.Win_t + (size_t)l * NIN * D, M, NIN, D}; pg8::StaticOrder S; S.init(M, NIN, F.G, (int)blockIdx.x);
            EpiInProj E{F.IB, F.rope, F.ssqp};
            pg8::gemm_phase<EpiInProj, pg8::StaticOrder, true, true>(F.lds + RING_OFF, g, S, E);
            if (BOTH(pb)) GRID_BAR();
        }
        if (IN(pb + 1)) {
            mixer_a(F, l); mixer_b(F, l); mixer_c(F, l); mixer_d(F, l);
            if (BOTH(pb + 1)) GRID_BAR();
        }
        if (IN(pb + 2)) {
            pg8::Gemm g{F.Y, F.Wout_t + (size_t)l * D * D, M, D, D}; pg8::StaticOrder S; S.init(M, D, F.G, (int)blockIdx.x);
            EpiOutProj E{l == 0 ? F.x : F.out, F.out, l + 1 < DEPTH ? F.XN : nullptr, F.ssqp};
            pg8::gemm_phase<EpiOutProj, pg8::StaticOrder, false, true>(F.lds + RING_OFF, g, S, E);
            if (BOTH(pb + 2)) GRID_BAR();
        }
        if (IN(pb + 3) && l + 1 == DEPTH) {
            const int tid_ = opaque_tid(), lane_ = tid_ & 63, wave_ = __builtin_amdgcn_readfirstlane(tid_ >> 6);
            const int gw = F.vcu * NWAVES + wave_, NGW = F.G * NWAVES;
            for (int m = gw; m < M; m += NGW) rms_row_final(lane_, F.out + (size_t)m * D, F.out + (size_t)m * D, F.final_g, F.ssqp, m);
        }
    }
#undef IN
#undef BOTH
}

extern "C" void kernel_launch(void* const* d_in, const int* in_sizes, int n_in, void* d_out, int out_size, void* d_ws, size_t ws_size, hipStream_t stream) {
    static int grid = 0;
    if (grid == 0) {
        if (n_in != 12 || in_sizes[0] != M * D || out_size != M * D || ws_size < WS_END) { fprintf(stderr, "kernel_launch: unexpected shapes (n_in %d, in0 %d, out %d, ws %zu); nothing launched\n", n_in, n_in > 0 ? in_sizes[0] : -1, out_size, ws_size); grid = -1; return; }
        int dev = 0, cus = 0, per_cu = 0;
        if (hipGetDevice(&dev) != hipSuccess || hipDeviceGetAttribute(&cus, hipDeviceAttributeMultiprocessorCount, dev) != hipSuccess) { grid = -1; return; }
        if (hipFuncSetAttribute((const void*)hymba_fwd, hipFuncAttributeMaxDynamicSharedMemorySize, LDS_BYTES) != hipSuccess) { fprintf(stderr, "kernel_launch: hipFuncSetAttribute failed\n"); grid = -1; return; }
        if (hipOccupancyMaxActiveBlocksPerMultiprocessor(&per_cu, (const void*)hymba_fwd, NWAVES * 64, LDS_BYTES) != hipSuccess || per_cu < 1)
            fprintf(stderr, "kernel_launch: note: occupancy query reports %d workgroups per CU\n", per_cu);
        (void)hipGetLastError();
        grid = cus;
    }
    if (grid < 0) return;
    if (hipMemsetAsync((char*)d_ws + WS_CTL, 0, CTL_ZERO_BYTES, stream) != hipSuccess) return;
    Args a{};
    for (int i = 0; i < 12; ++i) a.in[i] = (const float*)d_in[i];
    a.out = (float*)d_out; a.ws = (unsigned char*)d_ws;
    if (N_LAUNCHES == 1) {
        a.ph_lo = 0; a.ph_hi = N_PHASES; a.li = 0;
        hipLaunchKernelGGL(hymba_fwd, dim3(grid), dim3(NWAVES * 64), LDS_BYTES, stream, a);
    } else {
        for (int li = 0; li < N_PHASES; ++li) { a.ph_lo = li; a.ph_hi = li + 1; a.li = li;
            hipLaunchKernelGGL(hymba_fwd, dim3(grid), dim3(NWAVES * 64), LDS_BYTES, stream, a); }
    }
}
```

```cpp
#include <hip/hip_runtime.h>
#include <cstdio>
#include <cstdint>

#ifndef MK_N_LAUNCHES
#define MK_N_LAUNCHES 1
#endif

namespace pg8 {
#define PG8_LAS __attribute__((address_space(3)))
typedef unsigned short bf16_t;
typedef short bf16x8 __attribute__((ext_vector_type(8)));
typedef float f32x4 __attribute__((ext_vector_type(4)));
typedef unsigned u32x4 __attribute__((ext_vector_type(4)));
constexpr int BM = 256, BK = 64, HALF = 128, HTB = HALF * BK * 2  , STAGE_BYTES = 8 * HTB, NXCD = 8, WGM = 8;

__host__ __device__ __forceinline__ int lds_byte(int r, int c) { const int st = (r >> 4) * 2 + (c >> 5), rr = r & 15, cc = c & 31, ob = rr * 64 + cc * 2; return st * 1024 + (ob ^ (((ob >> 9) & 1) << 5)); }
__host__ __device__ __forceinline__ void stage_rc(int b, int& R, int& C) { const int st = b / 1024, sb = b % 1024, swz = sb ^ (((sb >> 9) & 1) << 5); R = (st >> 1) * 16 + swz / 64; C = (st & 1) * 32 + (swz % 64) / 2; }
__host__ __device__ __forceinline__ int perm32(int rho) { const int n = rho >> 4, i = rho & 15; return 8 * (i >> 2) + 4 * n + (i & 3); }

struct Unit { int pm, pn; };
struct Gemm { const bf16_t* A; const bf16_t* Bt; int M, N, K; };

struct StaticOrder {
    int nM, nN, nwg, G, c;
    __host__ __device__ void init(int M, int N, int G_, int c_) { nM = M / BM; nN = N / BM; nwg = nM * nN; G = G_; c = c_; }
    __host__ __device__ bool next(int i, Unit& u) const {
        const long L = (long)i * G + c; if (L >= nwg) return false;
        int wgid = (int)L; { const int q = nwg / NXCD, r = nwg % NXCD, xcd = wgid % NXCD, off = wgid / NXCD; wgid = (xcd < r ? xcd * (q + 1) : r * (q + 1) + (xcd - r) * q) + off; }
        const int nig = WGM * nN, gid = wgid / nig, fm = gid * WGM, gsz = (nM - fm) < WGM ? (nM - fm) : WGM;
        u.pm = fm + ((wgid % nig) % gsz); u.pn = (wgid % nig) / gsz; return true;
    }
    __device__ __forceinline__ void a_ready(const Unit&) const {}
    __device__ __forceinline__ void done(const Unit&) const {}
};

__device__ __forceinline__ unsigned cvt_pk_bf16(float lo, float hi) { unsigned r; asm volatile("v_cvt_pk_bf16_f32 %0, %1, %2" : "=v"(r) : "v"(lo), "v"(hi)); return r; }

template <class Epi, class Sched, bool ALIGN_EPI = false, bool SP2 = false>
__device__ __forceinline__ void gemm_phase(PG8_LAS unsigned char* lds, const Gemm g, const Sched& S, const Epi& E) {
    int tid = threadIdx.x; asm volatile("" : "+v"(tid));
    const int wid = __builtin_amdgcn_readfirstlane(tid >> 6), lane = tid & 63, wr = wid >> 2, wc = wid & 3, fr = lane & 15, fq = lane >> 4;
    const int K = g.K, nt = K / BK;
    unsigned voffA[2], voffB[2];
#pragma unroll
    for (int i = 0; i < 2; ++i) { int R, C; stage_rc(tid * 16 + i * 8192, R, C); const int Rb = Epi::PERM ? ((R & ~31) + perm32(R & 31)) : R;
        voffA[i] = (unsigned)(R * K + C) * 2u; voffB[i] = (unsigned)(Rb * K + C) * 2u; }
    const size_t kstep = (size_t)(BK * 2);
    const size_t hstep = (size_t)HALF * K * 2;
    const size_t tstep = 2 * hstep;
    const unsigned ldsw = (unsigned)wid * 1024u;
    const int aoff = lds_byte(wr * 64 + fr, fq * 8), boff = lds_byte(wc * 32 + fr, fq * 8);
#define PG8_SA(b, h) (((b) * 2 + (h)) * HTB)
#define PG8_SB(b, h) ((4 + (b) * 2 + (h)) * HTB)
#define PG8_STAGE(bufoff, gbase, voff) do { _Pragma("unroll") for (int _i = 0; _i < 2; ++_i) \
        __builtin_amdgcn_global_load_lds((const unsigned*)((const char*)(gbase) + (voff)[_i]), (PG8_LAS unsigned*)(lds + (bufoff) + ldsw + _i * 8192), 16, 0, 0); } while (0)
#define PG8_LDA(dst, b, h) do { _Pragma("unroll") for (int m = 0; m < 4; ++m) _Pragma("unroll") for (int k = 0; k < 2; ++k) dst[m][k] = *(const PG8_LAS bf16x8*)(lds + PG8_SA(b, h) + aoff + m * 2048 + k * 1024); } while (0)
#define PG8_LDB(dst, b, h) do { _Pragma("unroll") for (int n = 0; n < 2; ++n) _Pragma("unroll") for (int k = 0; k < 2; ++k) dst[n][k] = *(const PG8_LAS bf16x8*)(lds + PG8_SB(b, h) + boff + n * 2048 + k * 1024); } while (0)
#define PG8_MMA(ai, bj, At, Bt) do { __builtin_amdgcn_s_setprio(1); _Pragma("unroll") for (int m = 0; m < 4; ++m) _Pragma("unroll") for (int n = 0; n < 2; ++n) _Pragma("unroll") for (int k = 0; k < 2; ++k) \
        acc[ai][bj][m][n] = __builtin_amdgcn_mfma_f32_16x16x32_bf16(Bt[n][k], At[m][k], acc[ai][bj][m][n], 0, 0, 0); __builtin_amdgcn_s_setprio(0); } while (0)
#define PG8_WAIT_V(n) asm volatile("s_waitcnt vmcnt(" #n ")" ::: "memory")
#define PG8_WAIT_L(n) asm volatile("s_waitcnt lgkmcnt(" #n ")" ::: "memory")
#define PG8_BAR __builtin_amdgcn_s_barrier()
#define PG8_SCHED __builtin_amdgcn_sched_barrier(0)
    Unit cur, nxt; int ui = 0;
    if (!S.next(0, cur)) return;
    f32x4 acc[2][2][4][2];
#pragma unroll
    for (int a = 0; a < 2; ++a)
#pragma unroll
        for (int b = 0; b < 2; ++b)
#pragma unroll
            for (int m = 0; m < 4; ++m)
#pragma unroll
                for (int n = 0; n < 2; ++n) acc[a][b][m][n] = (f32x4){0.f, 0.f, 0.f, 0.f};
    bf16x8 At[4][2], B0[2][2], B1[2][2];
    const char* cA = (const char*)g.A + (size_t)cur.pm * tstep; const char* cB = (const char*)g.Bt + (size_t)cur.pn * tstep;
    S.a_ready(cur);
    if constexpr (SP2) {
        PG8_STAGE(PG8_SB(0, 0), cB, voffB); PG8_STAGE(PG8_SB(0, 1), cB + hstep, voffB); PG8_STAGE(PG8_SA(0, 0), cA, voffA); PG8_STAGE(PG8_SA(0, 1), cA + hstep, voffA);
        if (wr == 1) PG8_BAR;
        PG8_WAIT_V(2); PG8_BAR;
        PG8_STAGE(PG8_SB(1, 0), cB + kstep, voffB); PG8_STAGE(PG8_SA(1, 0), cA + kstep, voffA); PG8_STAGE(PG8_SB(1, 1), cB + hstep + kstep, voffB);
        PG8_WAIT_V(6); PG8_BAR;
    } else {
        PG8_STAGE(PG8_SB(0, 0), cB, voffB); PG8_STAGE(PG8_SA(0, 0), cA, voffA); PG8_STAGE(PG8_SB(0, 1), cB + hstep, voffB); PG8_STAGE(PG8_SA(0, 1), cA + hstep, voffA);
        if (wr == 1) PG8_BAR;
        PG8_WAIT_V(4); PG8_BAR;
        PG8_STAGE(PG8_SB(1, 0), cB + kstep, voffB); PG8_STAGE(PG8_SA(1, 0), cA + kstep, voffA); PG8_STAGE(PG8_SB(1, 1), cB + hstep + kstep, voffB);
        PG8_WAIT_V(6); PG8_BAR;
    }
    for (;;) {
        const bool has_next = S.next(ui + 1, nxt);
        const char* nA = has_next ? (const char*)g.A + (size_t)nxt.pm * tstep : cA; const char* nB = has_next ? (const char*)g.Bt + (size_t)nxt.pn * tstep : cB;
        for (int t = 0; t < nt; t += 2) {
            const bool last = (t == nt - 2);
            const char* a1 = cA + (size_t)(t + 1) * kstep;
            const char* a2 = last ? nA : cA + (size_t)(t + 2) * kstep; const char* b2 = last ? nB : cB + (size_t)(t + 2) * kstep;
            const char* a3 = a2 + kstep; const char* b3 = b2 + kstep;
            if (last && has_next) S.a_ready(nxt);
            if constexpr (SP2) {
            PG8_LDB(B0, 0, 0); PG8_LDB(B1, 0, 1); PG8_SCHED; PG8_LDA(At, 0, 0); PG8_STAGE(PG8_SA(1, 1), a1 + hstep, voffA);
            PG8_WAIT_V(8); PG8_WAIT_L(0); PG8_BAR; PG8_MMA(0, 0, At, B0); PG8_MMA(0, 1, At, B1); PG8_BAR; PG8_SCHED;
            PG8_LDA(At, 0, 1); PG8_STAGE(PG8_SB(0, 0), b2, voffB); PG8_STAGE(PG8_SB(0, 1), b2 + hstep, voffB); PG8_STAGE(PG8_SA(0, 0), a2, voffA);
            PG8_WAIT_V(8); PG8_WAIT_L(0); PG8_BAR; PG8_MMA(1, 0, At, B0); PG8_MMA(1, 1, At, B1); PG8_BAR; PG8_SCHED;
            PG8_LDB(B0, 1, 0); PG8_LDB(B1, 1, 1); PG8_SCHED; PG8_LDA(At, 1, 0); PG8_STAGE(PG8_SA(0, 1), a2 + hstep, voffA);
            PG8_WAIT_V(8); PG8_WAIT_L(0); PG8_BAR; PG8_MMA(0, 0, At, B0); PG8_MMA(0, 1, At, B1); PG8_BAR; PG8_SCHED;
            PG8_LDA(At, 1, 1); PG8_STAGE(PG8_SB(1, 0), b3, voffB); PG8_STAGE(PG8_SB(1, 1), b3 + hstep, voffB); PG8_STAGE(PG8_SA(1, 0), a3, voffA);
            PG8_WAIT_V(8); PG8_WAIT_L(0); PG8_BAR; PG8_MMA(1, 0, At, B0); PG8_MMA(1, 1, At, B1); PG8_BAR; PG8_SCHED;
            } else {
            PG8_LDB(B0, 0, 0); PG8_SCHED; PG8_LDA(At, 0, 0); PG8_STAGE(PG8_SA(1, 1), a1 + hstep, voffA);
            PG8_WAIT_L(8); PG8_BAR; PG8_WAIT_L(0); PG8_MMA(0, 0, At, B0); PG8_BAR; PG8_SCHED;
            PG8_LDB(B1, 0, 1); PG8_STAGE(PG8_SB(0, 0), b2, voffB);
            PG8_BAR; PG8_WAIT_L(0); PG8_MMA(0, 1, At, B1); PG8_BAR;
            PG8_LDA(At, 0, 1); PG8_STAGE(PG8_SA(0, 0), a2, voffA);
            PG8_BAR; PG8_WAIT_L(0); PG8_MMA(1, 0, At, B0); PG8_BAR; PG8_SCHED;
            PG8_STAGE(PG8_SB(0, 1), b2 + hstep, voffB);
            PG8_WAIT_V(6); PG8_BAR; PG8_MMA(1, 1, At, B1); PG8_BAR;
            PG8_LDB(B0, 1, 0); PG8_SCHED; PG8_LDA(At, 1, 0); PG8_STAGE(PG8_SA(0, 1), a2 + hstep, voffA);
            PG8_WAIT_L(8); PG8_BAR; PG8_WAIT_L(0); PG8_MMA(0, 0, At, B0); PG8_BAR; PG8_SCHED;
            PG8_LDB(B1, 1, 1); PG8_STAGE(PG8_SB(1, 0), b3, voffB);
            PG8_BAR; PG8_WAIT_L(0); PG8_MMA(0, 1, At, B1); PG8_BAR;
            PG8_LDA(At, 1, 1); PG8_STAGE(PG8_SA(1, 0), a3, voffA);
            PG8_BAR; PG8_WAIT_L(0); PG8_MMA(1, 0, At, B0); PG8_BAR; PG8_SCHED;
            PG8_STAGE(PG8_SB(1, 1), b3 + hstep, voffB);
            PG8_WAIT_V(6); PG8_BAR; PG8_MMA(1, 1, At, B1); PG8_BAR;
            }
        }
        if constexpr (ALIGN_EPI) { if (wr == 0) PG8_BAR; }
        if constexpr (!Epi::AFTER_DRAIN) { E(acc, cur, wr, wc, fr, fq); S.done(cur); }
        if (!has_next) break;
#pragma unroll
        for (int a = 0; a < 2; ++a)
#pragma unroll
            for (int b = 0; b < 2; ++b)
#pragma unroll
                for (int m = 0; m < 4; ++m)
#pragma unroll
                    for (int n = 0; n < 2; ++n) acc[a][b][m][n] = (f32x4){0.f, 0.f, 0.f, 0.f};
        cur = nxt; cA = nA; cB = nB; ++ui;
        if constexpr (ALIGN_EPI) { if (wr == 1) PG8_BAR; }
    }
    PG8_WAIT_V(0);
    if constexpr (!ALIGN_EPI) { if (wr == 0) PG8_BAR; }
    PG8_BAR;
    if constexpr (Epi::AFTER_DRAIN) { E.fused(acc, cur, wr, wc, fr, fq, lds, wid, lane); S.done(cur); }
#undef PG8_SA
#undef PG8_SB
#undef PG8_STAGE
#undef PG8_LDA
#undef PG8_LDB
#undef PG8_MMA
#undef PG8_WAIT_V
#undef PG8_WAIT_L
#undef PG8_BAR
#undef PG8_SCHED
}
}

constexpr int NWAVES = 8;
constexpr int N_LAUNCHES = MK_N_LAUNCHES;
constexpr int N_PHASES = 9;
constexpr int SEQ = 4096, NB = 4, M = NB * SEQ, D = 1024, NIN = 3584, DEPTH = 2;
constexpr float EPS = 1e-6f;
constexpr float LOG2E = 1.4426950408889634f;
constexpr float QSCALE = 0.125f * LOG2E;

constexpr size_t MiB = 1u << 20;
constexpr size_t WS_CTL = 0, CTL_ZERO_BYTES = 1 * MiB;
constexpr size_t WS_ROPE = 1 * MiB;
constexpr size_t WS_SSQ = 2 * MiB;
constexpr size_t WS_WIN = 4 * MiB;
constexpr size_t WS_WOUT = 18 * MiB;
constexpr size_t WS_XN = 24 * MiB;
constexpr size_t WS_Y = 56 * MiB;
constexpr size_t WS_I = 88 * MiB;
constexpr size_t WS_END = 176 * MiB;
enum { IB_H = 0, IB_AZ, IB_CX, IB_GB, IB_CQ, IB_CKV, IB_CZ, IB_DQ, IB_DK, IB_DV, IB_DZ, IB_N };
constexpr size_t IB_ELEMS = (size_t)M * 256;
constexpr int CW_TMO = 0, CW_CODE = 1;
constexpr int CW_BAR = 4096;

constexpr int RING_OFF = 0, RING_BYTES = 131072;
constexpr int LDSCTL_OFF = RING_BYTES, MISC_OFF = LDSCTL_OFF + 320;
constexpr int LDS_BYTES = 147456;

#define GAS __attribute__((address_space(1)))
#define LAS __attribute__((address_space(3)))
typedef unsigned short bf16;
typedef unsigned v4u __attribute__((ext_vector_type(4)));
typedef unsigned v2u __attribute__((ext_vector_type(2)));
typedef float f32x4 __attribute__((ext_vector_type(4)));
typedef float f32x2 __attribute__((ext_vector_type(2)));
typedef short bf16x8 __attribute__((ext_vector_type(8)));
typedef GAS unsigned gu32;
#define RLX_AGENT __ATOMIC_RELAXED, __HIP_MEMORY_SCOPE_AGENT
#define LDS_WAIT() asm volatile("s_waitcnt lgkmcnt(0)" ::: "memory")
#define VM_WAIT() asm volatile("s_waitcnt vmcnt(0)" ::: "memory")
__device__ __forceinline__ unsigned f2bf(float f) { unsigned u = __builtin_bit_cast(unsigned, f); return (u + 0x7fffu + ((u >> 16) & 1u)) >> 16; }
__device__ __forceinline__ unsigned pk2(float lo, float hi) { return f2bf(lo) | (f2bf(hi) << 16); }
__device__ __forceinline__ float bflo(unsigned w) { return __uint_as_float(w << 16); }
__device__ __forceinline__ float bfhi(unsigned w) { return __uint_as_float(w & 0xffff0000u); }
__device__ __forceinline__ float bf2f(bf16 v) { return __uint_as_float((unsigned)v << 16); }
__device__ __forceinline__ float sigmoidf_(float x) { return __builtin_amdgcn_rcpf(1.0f + __builtin_amdgcn_exp2f(-x * LOG2E)); }
__device__ __forceinline__ float siluf_(float x) { return x * sigmoidf_(x); }

#define XB_TMO      128
#define XB_XCNT(j)  (256  + 64 * (j))
#define XB_XSUB(j)  (1280 + 64 * (j))
#define XB_XGEN(j)  (2304 + 64 * (j))
#define XB_TOP      3328
#define XB_TOPGEN   3392
#define XCD_BAR_WORDS 3456
#define XB_SPIN_CAP (1u << 18)
__device__ __forceinline__ unsigned xb_ld(unsigned* p)              { return __hip_atomic_load(p, __ATOMIC_RELAXED, __HIP_MEMORY_SCOPE_AGENT); }
__device__ __forceinline__ unsigned xb_add(unsigned* p, unsigned v) { return __hip_atomic_fetch_add(p, v, __ATOMIC_RELAXED, __HIP_MEMORY_SCOPE_AGENT); }
__device__ __forceinline__ unsigned xb_xcc_id() { return (unsigned)__builtin_amdgcn_s_getreg((3 << 11) | 20) & 0xFu; }
#define XB_SPIN(cond, bar) do { unsigned _sp = 0; while (cond) { __builtin_amdgcn_s_sleep(1); \
    if ((++_sp & 255u) == 0u) { if (xb_ld(&(bar)[XB_TMO])) break; if (_sp > XB_SPIN_CAP) { atomicAdd(&(bar)[XB_TMO], 1u); break; } } } } while (0)
struct XcdBarrier { unsigned* bar; unsigned x; volatile LAS unsigned* st; };
__device__ __forceinline__ XcdBarrier xcd_barrier_post(unsigned* bar, volatile LAS unsigned* st) {
    XcdBarrier b; b.bar = bar; b.x = xb_xcc_id(); b.st = st;
    if (threadIdx.x == 0) (void)xb_add(&bar[XB_XCNT(b.x)], 1u);
    return b;
}
__device__ __forceinline__ void xcd_barrier_complete(unsigned* bar, unsigned x, unsigned& nloc, unsigned& nx) {
    const unsigned G = gridDim.x * gridDim.y * gridDim.z;
    unsigned sum, cnt, mine, sp = 0u;
    for (;;) {
        sum = 0u; cnt = 0u; mine = 0u;
#pragma unroll
        for (unsigned j = 0; j < 16; ++j) { const unsigned c = xb_ld(&bar[XB_XCNT(j)]); sum += c; cnt += (c > 0u) ? 1u : 0u; mine = (j == x) ? c : mine; }
        if (sum == G) break;
        __builtin_amdgcn_s_sleep(1);
        if ((++sp & 255u) == 0u) { if (xb_ld(&bar[XB_TMO])) break; if (sp > XB_SPIN_CAP) { atomicAdd(&bar[XB_TMO], 1u); break; } }
    }
    nloc = mine > 0u ? mine : 1u; nx = cnt > 0u ? cnt : 1u;
}
__device__ __forceinline__ void xcd_barrier(const XcdBarrier& b) {
    asm volatile("s_waitcnt vmcnt(0)" ::: "memory");
    __syncthreads();
    if (threadIdx.x == 0) {
        unsigned* bar = b.bar;
        __builtin_amdgcn_s_waitcnt(0);
        unsigned nloc = b.st[0], nx = b.st[1];
        if (nloc == 0u) { xcd_barrier_complete(bar, b.x, nloc, nx); b.st[0] = nloc; b.st[1] = nx; }
        const unsigned old = xb_add(&bar[XB_XSUB(b.x)], 1u);
        const unsigned gen = old / nloc;
        if (old + 1u == (gen + 1u) * nloc) {
            __builtin_amdgcn_fence(__ATOMIC_RELEASE, "agent");
            asm volatile("s_waitcnt vmcnt(0)" ::: "memory");
            const unsigned og = xb_add(&bar[XB_TOP], 1u);
            const unsigned tg = og / nx;
            if (og + 1u == (tg + 1u) * nx) xb_add(&bar[XB_TOPGEN], 1u);
            else XB_SPIN(xb_ld(&bar[XB_TOPGEN]) == tg, bar);
            __builtin_amdgcn_fence(__ATOMIC_ACQUIRE, "agent");
            xb_add(&bar[XB_XGEN(b.x)], 1u);
            asm volatile("s_waitcnt vmcnt(0)" ::: "memory");
        } else {
            XB_SPIN(xb_ld(&bar[XB_XGEN(b.x)]) == gen, bar);
            __builtin_amdgcn_fence(__ATOMIC_ACQUIRE, "agent");
            asm volatile("s_waitcnt vmcnt(0)" ::: "memory");
        }
    }
    __syncthreads();
}

struct Frame {
    LAS unsigned char* lds;
    volatile LAS unsigned* MISC;
    gu32* ctl;
    int tid, lane, wave;
    int vcu, G;
    const float* x; float* out;
    const float *norm_g, *w_in, *w_out, *conv_a_w, *conv_a_b, *ln_a_g, *ln_a_b, *conv_b_w, *swa_sink, *na_rpb, *final_g;
    bf16 *Win_t, *Wout_t, *XN, *Y, *IB;
    f32x2* rope; float* ssqp;
};

__device__ __forceinline__ int opaque_tid() { int t = threadIdx.x; asm volatile("" : "+v"(t)); return t; }
__device__ __forceinline__ float wave_sum(float v) {
#pragma unroll
    for (int o = 1; o < 64; o <<= 1) v += __shfl_xor(v, o);
    return v;
}
__device__ __forceinline__ float wave_max(float v) {
#pragma unroll
    for (int o = 1; o < 64; o <<= 1) v = fmaxf(v, __shfl_xor(v, o));
    return v;
}

__host__ __device__ __forceinline__ int sigma32(int nb  ) {
    const int pn = nb >> 3, g = nb & 7, half = g >> 2, jj = (g & 3) * 32;
    switch (pn) {
        case 0: return (half ? 256 : 0) + jj;
        case 1: return (half ? 256 : 0) + 128 + jj;
        case 2: return (half ? 1280 : 1024) + jj;
        case 3: return (half ? 1280 : 1024) + 128 + jj;
        case 4: return (half ? 1536 : 768) + jj;
        case 5: return (half ? 1536 : 768) + 128 + jj;
        case 6: return 512 + g * 32;
        case 7: return 1792 + 64 * (g & 3) + (half ? 32 : 0);
        case 8: return (g & 3) < 2 ? 2048 + 64 * (g & 3) + (half ? 32 : 0)
                                   : 2176 + 64 * half + 32 * ((g & 3) - 2);
        case 9: return 2304 + g * 32;
        case 10: return 2560 + g * 32;
        case 11: return 2816 + g * 32;
        case 12: return 3072 + g * 32;
        default: return 3328 + g * 32;
    }
}

__device__ __forceinline__ void p0_transpose_item(const float* W, int K, int N, bf16* WT, int k0, int nrow0, int src_col0, const float* gain, LAS float* scr, int lane) {
#pragma unroll 8
    for (int i = 0; i < 32; ++i) { const int kk = 2 * i + (lane >> 5); float w = W[(size_t)(k0 + kk) * N + src_col0 + (lane & 31)]; if (gain) w *= gain[k0 + kk]; scr[kk * 33 + (lane & 31)] = w; }
    LDS_WAIT(); asm volatile("" ::: "memory");
    const int c = lane & 7;
#pragma unroll
    for (int j = 0; j < 4; ++j) { const int n = (lane >> 3) + 8 * j; const LAS float* s = scr + (8 * c) * 33 + n;
        v4u o; o.x = pk2(s[0 * 33], s[1 * 33]); o.y = pk2(s[2 * 33], s[3 * 33]); o.z = pk2(s[4 * 33], s[5 * 33]); o.w = pk2(s[6 * 33], s[7 * 33]);
        *(GAS v4u*)(WT + (size_t)(nrow0 + n) * K + k0 + 8 * c) = o; }
    LDS_WAIT(); asm volatile("" ::: "memory");
}
__device__ __forceinline__ void row_to_bf16_ssq(int lane, const float* xrow, bf16* orow, float* ssqp, int m) {
    const GAS f32x4* xr = (const GAS f32x4*)xrow + lane;
    f32x4 v[4]; float s = 0.f;
#pragma unroll
    for (int j = 0; j < 4; ++j) { v[j] = xr[64 * j]; s += (v[j].x * v[j].x + v[j].y * v[j].y) + (v[j].z * v[j].z + v[j].w * v[j].w); }
    s = wave_sum(s);
    if (lane < 4) ssqp[(size_t)lane * M + m] = lane == 0 ? s : 0.f;
    GAS unsigned long long* o8 = (GAS unsigned long long*)orow + lane;
#pragma unroll
    for (int j = 0; j < 4; ++j) o8[64 * j] = (unsigned long long)pk2(v[j].x, v[j].y) | ((unsigned long long)pk2(v[j].z, v[j].w) << 32);
}
__device__ __forceinline__ void rms_row_final(int lane, const float* xrow, float* orow, const float* g, const float* ssqp, int m) {
    const GAS f32x4* xr = (const GAS f32x4*)xrow + lane;
    f32x4 v[4];
#pragma unroll
    for (int j = 0; j < 4; ++j) v[j] = xr[64 * j];
    const float rstd = 1.0f / sqrtf(((ssqp[m] + ssqp[M + m]) + (ssqp[2 * M + m] + ssqp[3 * M + m])) * (1.f / D) + EPS);
    GAS f32x4* o = (GAS f32x4*)orow + lane;
#pragma unroll
    for (int j = 0; j < 4; ++j) { const f32x4 gg = ((const GAS f32x4*)g)[lane + 64 * j]; o[64 * j] = v[j] * rstd * gg; }
}

__device__ __forceinline__ void p0_prologue(Frame& F) {
    const int tid_ = opaque_tid(), lane_ = tid_ & 63, wave_ = __builtin_amdgcn_readfirstlane(tid_ >> 6);
    LAS float* scr = (LAS float*)(F.lds + RING_OFF + wave_ * 16384);
    const int gw = F.vcu * NWAVES + wave_, NGW = F.G * NWAVES;
    constexpr int I_IN = (D / 64) * (NIN / 32), I_OUT = (D / 64) * (D / 32);
    constexpr int NITEMS = DEPTH * (I_IN + I_OUT);
    for (int it = gw; it < NITEMS; it += NGW) {
        int r = it; const int l = r / (I_IN + I_OUT); r -= l * (I_IN + I_OUT);
        if (r < I_IN) { const int nblk = NIN / 32, kb = r / nblk, nb = r % nblk;
            p0_transpose_item(F.w_in + (size_t)l * D * NIN, D, NIN, F.Win_t + (size_t)l * NIN * D, 64 * kb, 32 * nb, sigma32(nb), F.norm_g + l * D, scr, lane_); }
        else { r -= I_IN; const int nblk = D / 32, kb = r / nblk, nb = r % nblk;
            p0_transpose_item(F.w_out + (size_t)l * D * D, D, D, F.Wout_t + (size_t)l * D * D, 64 * kb, 32 * nb, 32 * nb, nullptr, scr, lane_); }
    }
    for (int i = gw * 64 + lane_; i < SEQ * 32; i += NGW * 64) {
        const int pos = i >> 5, d = i & 31;
        const float inv_freq = exp2f(-(float)d * (13.287712379549449f / 32.0f));
        const float ang = (float)pos * inv_freq;
        const double a = (double)ang; const double k = rint(a * 0.15915494309189535); const double rr = a - k * 6.283185307179586476925;
        F.rope[i] = (f32x2){(float)cos(rr), (float)sin(rr)};
    }
    for (int m = gw; m < M; m += NGW) row_to_bf16_ssq(lane_, F.x + (size_t)m * D, F.XN + (size_t)m * D, F.ssqp, m);
}

struct EpiInProj {
    static constexpr bool PERM = true, AFTER_DRAIN = false;
    bf16* IB; const f32x2* rope; const float* ssqp;
    __device__ __forceinline__ static v4u pack8(const f32x4 a, const f32x4 b) { v4u w; w.x = pg8::cvt_pk_bf16(a[0], a[1]); w.y = pg8::cvt_pk_bf16(a[2], a[3]); w.z = pg8::cvt_pk_bf16(b[0], b[1]); w.w = pg8::cvt_pk_bf16(b[2], b[3]); return w; }
    __device__ __forceinline__ void operator()(const f32x4 (&acc)[2][2][4][2], const pg8::Unit& u, int wr, int wc, int fr, int fq) const {
        const int pn = u.pn, row0 = u.pm * 256 + wr * 64 + fr, cl = wc * 32 + 8 * fq;
        float rs[2][4];
#pragma unroll
        for (int ai = 0; ai < 2; ++ai)
#pragma unroll
            for (int m = 0; m < 4; ++m) { const float* sp = ssqp + row0 + ai * 128 + m * 16; rs[ai][m] = 1.0f / sqrtf(((sp[0] + sp[M]) + (sp[2 * M] + sp[3 * M])) * (1.f / D) + EPS); }
        if (pn < 6) {
            bf16* O = IB + (size_t)(pn < 2 ? IB_H : pn < 4 ? IB_CX : IB_GB) * IB_ELEMS + 128 * (pn & 1) + cl;
#pragma unroll
            for (int ai = 0; ai < 2; ++ai)
#pragma unroll
                for (int m = 0; m < 4; ++m) {
                    f32x4 o[2];
#pragma unroll
                    for (int n = 0; n < 2; ++n) { const f32x4 a = acc[ai][0][m][n] * rs[ai][m], b = acc[ai][1][m][n] * rs[ai][m];
#pragma unroll
                        for (int i = 0; i < 4; ++i) o[n][i] = pn < 2 ? a[i] * sigmoidf_(b[i]) : pn < 4 ? a[i] * b[i] : a[i] * siluf_(b[i]); }
                    *(v4u*)(O + (size_t)(row0 + ai * 128 + m * 16) * 256) = pack8(o[0], o[1]);
                }
        } else if (pn == 7) {
            bf16* O = IB + (size_t)IB_CQ * IB_ELEMS + 64 * wc + 8 * fq;
#pragma unroll
            for (int ai = 0; ai < 2; ++ai)
#pragma unroll
                for (int m = 0; m < 4; ++m) { const int row = row0 + ai * 128 + m * 16; const f32x4* rp = (const f32x4*)(rope + (size_t)(row & (SEQ - 1)) * 32 + 8 * fq);
                    f32x4 o1[2], o2[2];
#pragma unroll
                    for (int n = 0; n < 2; ++n) { const f32x4 cs0 = rp[2 * n], cs1 = rp[2 * n + 1]; const f32x4 x1 = acc[ai][0][m][n] * (QSCALE * rs[ai][m]), x2 = acc[ai][1][m][n] * (QSCALE * rs[ai][m]);
                        o1[n][0] = x1[0] * cs0[0] - x2[0] * cs0[1]; o2[n][0] = x2[0] * cs0[0] + x1[0] * cs0[1];
                        o1[n][1] = x1[1] * cs0[2] - x2[1] * cs0[3]; o2[n][1] = x2[1] * cs0[2] + x1[1] * cs0[3];
                        o1[n][2] = x1[2] * cs1[0] - x2[2] * cs1[1]; o2[n][2] = x2[2] * cs1[0] + x1[2] * cs1[1];
                        o1[n][3] = x1[3] * cs1[2] - x2[3] * cs1[3]; o2[n][3] = x2[3] * cs1[2] + x1[3] * cs1[3]; }
                    *(v4u*)(O + (size_t)row * 256) = pack8(o1[0], o1[1]); *(v4u*)(O + (size_t)row * 256 + 32) = pack8(o2[0], o2[1]);
                    asm volatile("" ::: "memory"); }
        } else if (pn == 8) {
            if (wc < 2) {
                bf16* O = IB + (size_t)IB_CKV * IB_ELEMS + 64 * wc + 8 * fq;
#pragma unroll
                for (int ai = 0; ai < 2; ++ai)
#pragma unroll
                    for (int m = 0; m < 4; ++m) { const int row = row0 + ai * 128 + m * 16; const f32x4* rp = (const f32x4*)(rope + (size_t)(row & (SEQ - 1)) * 32 + 8 * fq);
                        f32x4 o1[2], o2[2];
#pragma unroll
                        for (int n = 0; n < 2; ++n) { const f32x4 cs0 = rp[2 * n], cs1 = rp[2 * n + 1]; const f32x4 x1 = acc[ai][0][m][n] * rs[ai][m], x2 = acc[ai][1][m][n] * rs[ai][m];
                            o1[n][0] = x1[0] * cs0[0] - x2[0] * cs0[1]; o2[n][0] = x2[0] * cs0[0] + x1[0] * cs0[1];
                            o1[n][1] = x1[1] * cs0[2] - x2[1] * cs0[3]; o2[n][1] = x2[1] * cs0[2] + x1[1] * cs0[3];
                            o1[n][2] = x1[2] * cs1[0] - x2[2] * cs1[1]; o2[n][2] = x2[2] * cs1[0] + x1[2] * cs1[1];
                            o1[n][3] = x1[3] * cs1[2] - x2[3] * cs1[3]; o2[n][3] = x2[3] * cs1[2] + x1[3] * cs1[3]; }
                        *(v4u*)(O + (size_t)row * 256) = pack8(o1[0], o1[1]); *(v4u*)(O + (size_t)row * 256 + 32) = pack8(o2[0], o2[1]);
                        asm volatile("" ::: "memory"); }
            } else {
                bf16* O = IB + (size_t)IB_CKV * IB_ELEMS + 128 + 32 * (wc - 2) + 8 * fq;
#pragma unroll
                for (int ai = 0; ai < 2; ++ai)
#pragma unroll
                    for (int m = 0; m < 4; ++m) { const int row = row0 + ai * 128 + m * 16;
#pragma unroll
                        for (int bj = 0; bj < 2; ++bj) *(v4u*)(O + (size_t)row * 256 + 64 * bj) = pack8(acc[ai][bj][m][0] * rs[ai][m], acc[ai][bj][m][1] * rs[ai][m]); }
            }
        } else {
            const int ib = pn == 6 ? IB_AZ : pn == 9 ? IB_CZ : pn == 10 ? IB_DQ : pn == 11 ? IB_DK : pn == 12 ? IB_DV : IB_DZ;
            const int mode = (pn == 6 || pn == 9 || pn == 13) ? 1 : (pn == 10 ? 2 : 0);
            bf16* O = IB + (size_t)ib * IB_ELEMS + cl;
#pragma unroll
            for (int ai = 0; ai < 2; ++ai)
#pragma unroll
                for (int m = 0; m < 4; ++m) { const int row = row0 + ai * 128 + m * 16;
#pragma unroll
                    for (int bj = 0; bj < 2; ++bj) { f32x4 v[2];
#pragma unroll
                        for (int n = 0; n < 2; ++n) { v[n] = acc[ai][bj][m][n] * rs[ai][m];
                            if (mode == 1) {
#pragma unroll
                                for (int i = 0; i < 4; ++i) v[n][i] = siluf_(v[n][i]); }
                            else if (mode == 2) v[n] = v[n] * QSCALE; }
                        *(v4u*)(O + (size_t)row * 256 + 128 * bj) = pack8(v[0], v[1]); } }
        }
    }
};
struct EpiOutProj {
    static constexpr bool PERM = true, AFTER_DRAIN = true;
    bf16* xn; float* out; float* ssqp;
    __device__ __forceinline__ void fused(f32x4 (&acc)[2][2][4][2], const pg8::Unit& u, int wr, int wc, int fr, int fq, LAS unsigned char* lds, int wid, int lane) const {
        const int row0 = u.pm * 256 + wr * 64 + fr, col0 = u.pn * 256 + wc * 32 + 8 * fq;
        LAS float* P = (LAS float*)lds;
#pragma unroll
        for (int ai = 0; ai < 2; ++ai)
#pragma unroll
            for (int m = 0; m < 4; ++m) { const size_t off = (size_t)(row0 + ai * 128 + m * 16) * D + col0; float q = 0.f;
#pragma unroll
                for (int bj = 0; bj < 2; ++bj) { const v4u xb = *(const v4u*)(xn + off + bj * 128);
                    const f32x4 v0 = (f32x4){bflo(xb.x), bfhi(xb.x), bflo(xb.y), bfhi(xb.y)} + acc[ai][bj][m][0], v1 = (f32x4){bflo(xb.z), bfhi(xb.z), bflo(xb.w), bfhi(xb.w)} + acc[ai][bj][m][1];
                    if (out) { *(f32x4*)(out + off + bj * 128) = v0; *(f32x4*)(out + off + bj * 128 + 4) = v1; }
                    else *(v4u*)(xn + off + bj * 128) = EpiInProj::pack8(v0, v1);
                    q += ((v0[0] * v0[0] + v0[1] * v0[1]) + (v0[2] * v0[2] + v0[3] * v0[3])) + ((v1[0] * v1[0] + v1[1] * v1[1]) + (v1[2] * v1[2] + v1[3] * v1[3])); }
                q += __shfl_xor(q, 16); q += __shfl_xor(q, 32);
                if (fq == 0) P[(ai * 128 + wr * 64 + m * 16 + fr) * 4 + wc] = q; }
        asm volatile("s_waitcnt lgkmcnt(0)" ::: "memory"); __builtin_amdgcn_s_barrier(); asm volatile("" ::: "memory");
        const int t = wid * 64 + lane;
        if (t < 256) { const f32x4 p = *(const LAS f32x4*)(P + 4 * t); ssqp[(size_t)u.pn * M + u.pm * 256 + t] = (p[0] + p[1]) + (p[2] + p[3]); }
    }
};

__device__ __forceinline__ void mixer_a(Frame& F, int layer) {
    LAS unsigned char* lds = F.lds;
    const bf16* H = F.IB + (size_t)IB_H * IB_ELEMS; const bf16* AZ = F.IB + (size_t)IB_AZ * IB_ELEMS;
    const float* cw = F.conv_a_w + layer * 31 * 256; const float* cb = F.conv_a_b + layer * 256; const float* lg = F.ln_a_g + layer * 256; const float* lb = F.ln_a_b + layer * 256;
    const int tid_ = opaque_tid(), lane_ = tid_ & 63, wave_ = __builtin_amdgcn_readfirstlane(tid_ >> 6);
    const int cp = tid_ & 127, tq = tid_ >> 7;
    for (int u = F.vcu; u < M / 64; u += F.G) {
        const int t0 = u * 64, s0 = t0 & (SEQ - 1), bbase = t0 - s0;
        { v4u tv[6];
#pragma unroll
            for (int it = 0; it < 6; ++it) { const int c = tid_ + 512 * it, i = c >> 5, ch = c & 31, s = s0 - 15 + i; tv[it] = (v4u){0u, 0u, 0u, 0u};
                if (i < 94 && s >= 0 && s < SEQ) tv[it] = *(const GAS v4u*)(H + (size_t)(bbase + s) * 256 + ch * 8); }
#pragma unroll
            for (int it = 0; it < 6; ++it) { const int c = tid_ + 512 * it, i = c >> 5, ch = c & 31; if (i < 94) *(LAS v4u*)(lds + i * 512 + ch * 16) = tv[it]; } }
        __syncthreads();
        {
            float w0[31], w1[31];
#pragma unroll
            for (int j = 0; j < 31; ++j) { const f32x2 w = *(const GAS f32x2*)(cw + j * 256 + 2 * cp); w0[j] = w.x; w1[j] = w.y; }
            const f32x2 bb = *(const GAS f32x2*)(cb + 2 * cp);
            float a0[16], a1[16];
#pragma unroll
            for (int o = 0; o < 16; ++o) { a0[o] = bb.x; a1[o] = bb.y; }
#pragma unroll
            for (int i = 0; i < 46; ++i) { const unsigned hv = *(const LAS unsigned*)(lds + (tq * 16 + i) * 512 + cp * 4); const float h0 = bflo(hv), h1 = bfhi(hv);
#pragma unroll
                for (int o = 0; o < 16; ++o) { const int j = i - o; if (j >= 0 && j <= 30) { a0[o] += w0[j] * h0; a1[o] += w1[j] * h1; } } }
#pragma unroll
            for (int o = 0; o < 16; ++o) *(LAS f32x2*)(lds + 49152 + ((tq * 16 + o) * 256 + 2 * cp) * 4) = (f32x2){a0[o], a1[o]};
        }
        __syncthreads();
        {
            const f32x4 g4 = *(const GAS f32x4*)(lg + 4 * lane_), b4 = *(const GAS f32x4*)(lb + 4 * lane_);
            f32x4 xv[8]; v2u az[8]; float sm[8];
#pragma unroll
            for (int k = 0; k < 8; ++k) { const int tok = 8 * wave_ + k; xv[k] = *(const LAS f32x4*)(lds + 49152 + (tok * 256 + 4 * lane_) * 4);
                az[k] = *(const GAS v2u*)(AZ + (size_t)(t0 + tok) * 256 + 4 * lane_); sm[k] = (xv[k].x + xv[k].y) + (xv[k].z + xv[k].w); }
#pragma unroll
            for (int o = 1; o < 64; o <<= 1)
#pragma unroll
                for (int k = 0; k < 8; ++k) sm[k] += __shfl_xor(sm[k], o);
#pragma unroll
            for (int k = 0; k < 8; ++k) { xv[k] = xv[k] - sm[k] * (1.f / 256.f); sm[k] = (xv[k].x * xv[k].x + xv[k].y * xv[k].y) + (xv[k].z * xv[k].z + xv[k].w * xv[k].w); }
#pragma unroll
            for (int o = 1; o < 64; o <<= 1)
#pragma unroll
                for (int k = 0; k < 8; ++k) sm[k] += __shfl_xor(sm[k], o);
#pragma unroll
            for (int k = 0; k < 8; ++k) { const int tok = 8 * wave_ + k; const float rstd = 1.0f / sqrtf(sm[k] * (1.f / 256.f) + EPS);
                const f32x4 y = xv[k] * rstd * g4 + b4;
                v2u o; o.x = pk2(siluf_(y.x) * bflo(az[k].x), siluf_(y.y) * bfhi(az[k].x)); o.y = pk2(siluf_(y.z) * bflo(az[k].y), siluf_(y.w) * bfhi(az[k].y));
                *(GAS v2u*)(F.Y + (size_t)(t0 + tok) * D + 4 * lane_) = o; }
        }
        __syncthreads();
    }
}
__device__ __forceinline__ void mixer_b(Frame& F, int layer) {
    const bf16* CX = F.IB + (size_t)IB_CX * IB_ELEMS; const bf16* GB = F.IB + (size_t)IB_GB * IB_ELEMS; const float* w = F.conv_b_w + layer * 3 * 256;
    const int tid_ = opaque_tid(), ch = (tid_ & 31) * 8;
    f32x4 wv[3][2];
#pragma unroll
    for (int j = 0; j < 3; ++j) { wv[j][0] = *(const GAS f32x4*)(w + j * 256 + ch); wv[j][1] = *(const GAS f32x4*)(w + j * 256 + ch + 4); }
    constexpr int NIT = (M * 32) / (256 * 512);
    for (int base = F.vcu * 512 + tid_; base < M * 32; base += F.G * 512 * NIT) {
        v4u xm[NIT], x0[NIT], xp[NIT], gb[NIT];
#pragma unroll
        for (int k = 0; k < NIT; ++k) { const int it = base + k * F.G * 512, t = it >> 5, s = t & (SEQ - 1); const v4u z = (v4u){0u, 0u, 0u, 0u};
            if (it < M * 32) { xm[k] = s > 0 ? *(const GAS v4u*)(CX + (size_t)(t - 1) * 256 + ch) : z; x0[k] = *(const GAS v4u*)(CX + (size_t)t * 256 + ch);
                xp[k] = s < SEQ - 1 ? *(const GAS v4u*)(CX + (size_t)(t + 1) * 256 + ch) : z; gb[k] = *(const GAS v4u*)(GB + (size_t)t * 256 + ch); } }
#pragma unroll
        for (int k = 0; k < NIT; ++k) { const int it = base + k * F.G * 512, t = it >> 5;
            if (it < M * 32) { v4u o;
#pragma unroll
                for (int q = 0; q < 4; ++q) { const int e = (2 * q) & 3, hv = (2 * q) >> 2;
                    const float r0 = wv[0][hv][e] * bflo(xm[k][q]) + wv[1][hv][e] * bflo(x0[k][q]) + wv[2][hv][e] * bflo(xp[k][q]);
                    const float r1 = wv[0][hv][e + 1] * bfhi(xm[k][q]) + wv[1][hv][e + 1] * bfhi(x0[k][q]) + wv[2][hv][e + 1] * bfhi(xp[k][q]);
                    o[q] = pk2(bflo(gb[k][q]) * r0, bfhi(gb[k][q]) * r1); }
                *(GAS v4u*)(F.Y + (size_t)t * D + 256 + ch) = o; } }
    }
}
typedef short v4i16_t __attribute__((ext_vector_type(4)));
constexpr int ATT_PITCH = 144;
struct AttnState { float m, l; f32x4 negm; f32x4 o[4]; };
constexpr float ATT_THR = 8.0f;
__device__ __forceinline__ bf16x8 vtr2(const LAS unsigned char* p) {
    const v4i16_t lo = __builtin_amdgcn_ds_read_tr16_b64_v4i16((LAS v4i16_t*)p), hi = __builtin_amdgcn_ds_read_tr16_b64_v4i16((LAS v4i16_t*)(p + 16 * ATT_PITCH));
    return (bf16x8){lo[0], lo[1], lo[2], lo[3], hi[0], hi[1], hi[2], hi[3]};
}
__device__ __forceinline__ void attn_init(AttnState& st, float m0, float l0) {
    st.m = m0; st.l = l0; st.negm = (f32x4){-m0, -m0, -m0, -m0};
#pragma unroll
    for (int dt = 0; dt < 4; ++dt) st.o[dt] = (f32x4){0.f, 0.f, 0.f, 0.f};
}
template <bool FIRST>
__device__ __forceinline__ void attn_step(AttnState& st, f32x4 s0, f32x4 s1, const bf16x8 (&vf)[4]) {
    float mx = fmaxf(fmaxf(fmaxf(s0[0], s0[1]), fmaxf(s0[2], s0[3])), fmaxf(fmaxf(s1[0], s1[1]), fmaxf(s1[2], s1[3])));
    if (FIRST || __any(mx > ATT_THR)) {
        mx = fmaxf(mx, __shfl_xor(mx, 16)); mx = fmaxf(mx, __shfl_xor(mx, 32));
        const float d = FIRST ? mx : fmaxf(mx, 0.f);
        if (!FIRST) { const float a = __builtin_amdgcn_exp2f(-d); st.l *= a;
#pragma unroll
            for (int dt = 0; dt < 4; ++dt) st.o[dt] = st.o[dt] * a; }
        st.m += d; st.negm = (f32x4){-st.m, -st.m, -st.m, -st.m}; s0 = s0 - d; s1 = s1 - d;
    }
    f32x4 p0, p1;
#pragma unroll
    for (int r = 0; r < 4; ++r) { p0[r] = __builtin_amdgcn_exp2f(s0[r]); p1[r] = __builtin_amdgcn_exp2f(s1[r]); }
    st.l += ((p0[0] + p0[1]) + (p0[2] + p0[3])) + ((p1[0] + p1[1]) + (p1[2] + p1[3]));
    v4u pw; pw.x = pg8::cvt_pk_bf16(p0[0], p0[1]); pw.y = pg8::cvt_pk_bf16(p0[2], p0[3]); pw.z = pg8::cvt_pk_bf16(p1[0], p1[1]); pw.w = pg8::cvt_pk_bf16(p1[2], p1[3]);
    const bf16x8 pf = __builtin_bit_cast(bf16x8, pw);
#pragma unroll
    for (int dt = 0; dt < 4; ++dt) st.o[dt] = __builtin_amdgcn_mfma_f32_16x16x32_bf16(vf[dt], pf, st.o[dt], 0, 0, 0);
}
__device__ __forceinline__ void attn_finish(const AttnState& st, const bf16* gate_row, bf16* out_row, int g) {
    float l = st.l; l += __shfl_xor(l, 16); l += __shfl_xor(l, 32); const float inv = 1.0f / l;
#pragma unroll
    for (int dt = 0; dt < 4; ++dt) { const v2u gz = *(const GAS v2u*)(gate_row + 16 * dt + 4 * g); const f32x4 o = st.o[dt] * inv;
        v2u w; w.x = pk2(o[0] * bflo(gz.x), o[1] * bfhi(gz.x)); w.y = pk2(o[2] * bflo(gz.y), o[3] * bfhi(gz.y));
        *(GAS v2u*)(out_row + 16 * dt + 4 * g) = w; }
}
#define MFMA16(a, b, c) __builtin_amdgcn_mfma_f32_16x16x32_bf16(a, b, c, 0, 0, 0)
__device__ __forceinline__ void mixer_c(Frame& F, int layer) {
    const bf16* CQ = F.IB + (size_t)IB_CQ * IB_ELEMS; const bf16* CKV = F.IB + (size_t)IB_CKV * IB_ELEMS; const bf16* CZ = F.IB + (size_t)IB_CZ * IB_ELEMS;
    const int tid_ = opaque_tid(), lane = tid_ & 63, wave_ = __builtin_amdgcn_readfirstlane(tid_ >> 6), g = lane >> 4, li = lane & 15;
    LAS unsigned char* Kl = F.lds; LAS unsigned char* Vl = F.lds + 384 * ATT_PITCH;
    for (int u = F.vcu; u < NB * 32 * 2; u += F.G) {
        const int kvh = u & 1, n = (u >> 1) & 31, b = u >> 6;
        const int tq0 = b * SEQ + n * 128, tk0 = tq0 - 128, kk_lo = n == 0 ? 128 : 0, kk_hi = n == 31 ? 255 : 383;
        __syncthreads();
        { v4u tk[6], tv[6];
#pragma unroll
            for (int it = 0; it < 6; ++it) { const int c = tid_ + 512 * it, row = c >> 3, ch = c & 7; int tok = tk0 + row; tok = tok < b * SEQ ? b * SEQ : (tok > b * SEQ + SEQ - 1 ? b * SEQ + SEQ - 1 : tok);
                const bf16* src = CKV + (size_t)tok * 256 + 64 * kvh + 8 * ch; tk[it] = *(const GAS v4u*)src; tv[it] = *(const GAS v4u*)(src + 128); }
#pragma unroll
            for (int it = 0; it < 6; ++it) { const int c = tid_ + 512 * it, row = c >> 3, ch = c & 7; *(LAS v4u*)(Kl + row * ATT_PITCH + ch * 16) = tk[it]; *(LAS v4u*)(Vl + row * ATT_PITCH + ch * 16) = tv[it]; } }
        const int hq = 2 * kvh + (wave_ >> 2), wq = wave_ & 3;
        bf16x8 qf[2][2];
#pragma unroll
        for (int qt = 0; qt < 2; ++qt)
#pragma unroll
            for (int ks = 0; ks < 2; ++ks) qf[qt][ks] = *(const GAS bf16x8*)(CQ + (size_t)(tq0 + 32 * wq + 16 * qt + li) * 256 + 64 * hq + 32 * ks + 8 * g);
        const float sink = F.swa_sink[layer * 4 + hq] * LOG2E;
        AttnState st[2];
        attn_init(st[0], sink, g == 0 ? 1.0f : 0.0f); attn_init(st[1], sink, g == 0 ? 1.0f : 0.0f);
        __syncthreads();
#pragma unroll 1
        for (int s = 0; s < 9; ++s) { const int kb = 32 * wq + 32 * s; if (kb < kk_lo || kb > kk_hi) continue;
            bf16x8 kf[2][2], vf[4];
#pragma unroll
            for (int kt = 0; kt < 2; ++kt)
#pragma unroll
                for (int ks = 0; ks < 2; ++ks) kf[kt][ks] = *(const LAS bf16x8*)(Kl + (kb + 16 * kt + li) * ATT_PITCH + (32 * ks + 8 * g) * 2);
#pragma unroll
            for (int dt = 0; dt < 4; ++dt) vf[dt] = vtr2(Vl + (kb + 4 * g + (li >> 2)) * ATT_PITCH + (16 * dt + 4 * (li & 3)) * 2);
#pragma unroll
            for (int qt = 0; qt < 2; ++qt) {
                f32x4 s0 = MFMA16(kf[0][0], qf[qt][0], st[qt].negm); s0 = MFMA16(kf[0][1], qf[qt][1], s0);
                f32x4 s1 = MFMA16(kf[1][0], qf[qt][0], st[qt].negm); s1 = MFMA16(kf[1][1], qf[qt][1], s1);
                if (s == 0 || s == 8) { const int qrel = 16 * qt + li;
#pragma unroll
                    for (int r = 0; r < 4; ++r) { const int k0 = 4 * g + r, k1 = 16 + 4 * g + r;
                        const bool v0 = s == 0 ? k0 >= qrel : k0 <= qrel, v1 = s == 0 ? k1 >= qrel : k1 <= qrel;
                        s0[r] = v0 ? s0[r] : -INFINITY; s1[r] = v1 ? s1[r] : -INFINITY; } }
                attn_step<false>(st[qt], s0, s1, vf); }
        }
#pragma unroll
        for (int qt = 0; qt < 2; ++qt) { const size_t tok = (size_t)(tq0 + 32 * wq + 16 * qt + li);
            attn_finish(st[qt], CZ + tok * 256 + 64 * hq, F.Y + tok * D + 512 + 64 * hq, g); }
    }
}
constexpr int NA_BIAS_OFF = 11 * 64 * ATT_PITCH;
template <bool F0, bool F1, bool A0, bool A1>
__device__ __forceinline__ void na_step(AttnState& st0, AttnState& st1, const bf16x8 (&kf)[2][2], const bf16x8 (&qf)[2][2], const bf16x8 (&vf)[4], const LAS float* brow0, const LAS float* brow1, int g, int lo) {
    float bz0[4], bz1[4], by0[4], by1[4];
#pragma unroll
    for (int q = 0; q < 4; ++q) { if (A0) { bz0[q] = brow0[4 * g + q]; bz1[q] = brow0[16 + 4 * g + q]; } if (A1) { by0[q] = brow1[4 * g + q]; by1[q] = brow1[16 + 4 * g + q]; } }
    if (A0) { f32x4 s0 = MFMA16(kf[0][0], qf[0][0], st0.negm); s0 = MFMA16(kf[0][1], qf[0][1], s0); f32x4 s1 = MFMA16(kf[1][0], qf[0][0], st0.negm); s1 = MFMA16(kf[1][1], qf[0][1], s1);
#pragma unroll
        for (int q = 0; q < 4; ++q) { const int k0 = 4 * g + q, k1 = 16 + 4 * g + q;
            s0[q] = (k0 >= lo && k0 <= lo + 15) ? s0[q] + bz0[q] : -INFINITY; s1[q] = (k1 >= lo && k1 <= lo + 15) ? s1[q] + bz1[q] : -INFINITY; }
        attn_step<F0>(st0, s0, s1, vf); }
    if (A1) { f32x4 s0 = MFMA16(kf[0][0], qf[1][0], st1.negm); s0 = MFMA16(kf[0][1], qf[1][1], s0); f32x4 s1 = MFMA16(kf[1][0], qf[1][0], st1.negm); s1 = MFMA16(kf[1][1], qf[1][1], s1);
#pragma unroll
        for (int q = 0; q < 4; ++q) { const int k0 = 4 * g + q, k1 = 16 + 4 * g + q;
            s0[q] = (k0 >= lo && k0 <= lo + 15) ? s0[q] + by0[q] : -INFINITY; s1[q] = (k1 >= lo && k1 <= lo + 15) ? s1[q] + by1[q] : -INFINITY; }
        attn_step<F1>(st1, s0, s1, vf); }
}
__device__ __forceinline__ void mixer_d(Frame& F, int layer) {
    const bf16* DQ = F.IB + (size_t)IB_DQ * IB_ELEMS; const bf16* DK = F.IB + (size_t)IB_DK * IB_ELEMS; const bf16* DV = F.IB + (size_t)IB_DV * IB_ELEMS; const bf16* DZ = F.IB + (size_t)IB_DZ * IB_ELEMS;
    const int tid_ = opaque_tid(), lane = tid_ & 63, wave_ = __builtin_amdgcn_readfirstlane(tid_ >> 6), g = lane >> 4, li = lane & 15;
    LAS unsigned char* Vl = F.lds; LAS float* bias = (LAS float*)(F.lds + NA_BIAS_OFF);
    for (int u = F.vcu; u < NB * 4 * 16; u += F.G) {
        const int rq = u & 15, h = (u >> 4) & 3, b = u >> 6, ra = 4 * rq;
        const int lo_row = ra - 4 < 0 ? 0 : (ra - 4 > 56 ? 56 : ra - 4), hi_r0 = ra - 1 > 56 ? 56 : ra - 1  ;
        const int hi_row = (hi_r0 < 0 ? 0 : hi_r0) + 7, nrows = hi_row - lo_row + 1;
        const size_t tb = (size_t)b * SEQ;
        __syncthreads();
        { v4u tv[11];
#pragma unroll
            for (int it = 0; it < 11; ++it) { const int gr = lo_row + it > 63 ? 63 : lo_row + it; tv[it] = *(const GAS v4u*)(DV + (tb + gr * 64 + (tid_ >> 3)) * 256 + 64 * h + 8 * (tid_ & 7)); }
#pragma unroll
            for (int it = 0; it < 11; ++it) *(LAS v4u*)(Vl + (it * 64 + (tid_ >> 3)) * ATT_PITCH + (tid_ & 7) * 16) = tv[it]; }
        for (int c = tid_; c < 544; c += 512) { const int e = c - 32; bias[c] = (e >= 0 && e < 465) ? F.na_rpb[(size_t)(layer * 4 + h) * 465 + e] * LOG2E : 0.f; }
        const int rpw = wave_ >> 2, qg = wave_ & 3, rA = ra + 2 * rpw, rB = rA + 1;
        const int r0A = rA - 4 < 0 ? 0 : (rA - 4 > 56 ? 56 : rA - 4), r0B = rB - 4 < 0 ? 0 : (rB - 4 > 56 ? 56 : rB - 4), dB = r0B - r0A;
        const int wc0 = qg == 0 ? 0 : qg == 1 ? 8 : qg == 2 ? 24 : 32;
        const int c = 16 * qg + li, c0 = c - 8 < 0 ? 0 : (c - 8 > 48 ? 48 : c - 8), lo = c0 - wc0;
        const size_t tokA = tb + rA * 64 + c, tokB = tokA + 64;
        bf16x8 qf[2][2];
#pragma unroll
        for (int ks = 0; ks < 2; ++ks) { qf[0][ks] = *(const GAS bf16x8*)(DQ + tokA * 256 + 64 * h + 32 * ks + 8 * g); qf[1][ks] = *(const GAS bf16x8*)(DQ + tokB * 256 + 64 * h + 32 * ks + 8 * g); }
        AttnState stA, stB; attn_init(stA, 0.f, 0.f); attn_init(stB, 0.f, 0.f);
        const bf16* kbase = DK + (tb + wc0 + li) * 256 + 64 * h + 8 * g;
        bf16x8 kfr[2][2][2];
#define NA_KLOAD(slot, j) do { const int kr_ = (r0A + (j)) > 63 ? 63 : (r0A + (j)); _Pragma("unroll") for (int kt = 0; kt < 2; ++kt) _Pragma("unroll") for (int ks = 0; ks < 2; ++ks) \
            kfr[slot][kt][ks] = *(const GAS bf16x8*)(kbase + (size_t)(kr_ * 64 + 16 * kt) * 256 + 32 * ks); } while (0)
        NA_KLOAD(0, 0); NA_KLOAD(1, 1);
        __syncthreads();
        const LAS float* bcol = bias + 32 + (wc0 - c + 15);
        const LAS unsigned char* vbase = Vl + ((r0A - lo_row) * 64 + wc0 + 4 * g + (li >> 2)) * ATT_PITCH + (4 * (li & 3)) * 2;
#define NA_STEP(j, F0, F1, A0, A1) do { bf16x8 vf[4]; _Pragma("unroll") for (int dt = 0; dt < 4; ++dt) vf[dt] = vtr2(vbase + (j) * 64 * ATT_PITCH + 32 * dt); \
            na_step<F0, F1, A0, A1>(stA, stB, kfr[(j) & 1], qf, vf, bcol + (r0A + (j) - rA + 7) * 31, bcol + (r0A + (j) - rB + 7) * 31, g, lo); } while (0)
        if (dB == 0) {
            NA_STEP(0, true, true, true, true);   NA_KLOAD(0, 2);
            NA_STEP(1, false, false, true, true); NA_KLOAD(1, 3);
            NA_STEP(2, false, false, true, true); NA_KLOAD(0, 4);
            NA_STEP(3, false, false, true, true); NA_KLOAD(1, 5);
            NA_STEP(4, false, false, true, true); NA_KLOAD(0, 6);
            NA_STEP(5, false, false, true, true); NA_KLOAD(1, 7);
            NA_STEP(6, false, false, true, true);
            NA_STEP(7, false, false, true, true);
        } else {
            NA_STEP(0, true, false, true, false); NA_KLOAD(0, 2);
            NA_STEP(1, false, true, true, true);  NA_KLOAD(1, 3);
            NA_STEP(2, false, false, true, true); NA_KLOAD(0, 4);
            NA_STEP(3, false, false, true, true); NA_KLOAD(1, 5);
            NA_STEP(4, false, false, true, true); NA_KLOAD(0, 6);
            NA_STEP(5, false, false, true, true); NA_KLOAD(1, 7);
            NA_STEP(6, false, false, true, true); NA_KLOAD(0, 8);
            NA_STEP(7, false, false, true, true);
            NA_STEP(8, false, false, false, true);
        }
#undef NA_STEP
#undef NA_KLOAD
        attn_finish(stA, DZ + tokA * 256 + 64 * h, F.Y + tokA * D + 768 + 64 * h, g);
        attn_finish(stB, DZ + tokB * 256 + 64 * h, F.Y + tokB * D + 768 + 64 * h, g);
    }
}

struct Args { const float* in[12]; float* out; unsigned char* ws; int ph_lo, ph_hi, li, pad; };
__global__ void __launch_bounds__(NWAVES * 64, 2) hymba_fwd(Args args) {
    extern __shared__ __attribute__((aligned(16))) unsigned char lds[];
    Frame F;
    F.lds = (LAS unsigned char*)lds;
    F.MISC = (volatile LAS unsigned*)(F.lds + MISC_OFF);
    F.tid = threadIdx.x; F.lane = F.tid & 63; F.wave = __builtin_amdgcn_readfirstlane(F.tid >> 6);
    F.G = gridDim.x; { const int bx = blockIdx.x; F.vcu = (F.G % 8 == 0) ? (bx % 8) * (F.G / 8) + bx / 8 : bx; }
    unsigned char* ws = args.ws;
    F.ctl = (gu32*)(ws + WS_CTL);
    F.x = args.in[0]; F.norm_g = args.in[1]; F.w_in = args.in[2]; F.w_out = args.in[3]; F.conv_a_w = args.in[4]; F.conv_a_b = args.in[5]; F.ln_a_g = args.in[6]; F.ln_a_b = args.in[7];
    F.conv_b_w = args.in[8]; F.swa_sink = args.in[9]; F.na_rpb = args.in[10]; F.final_g = args.in[11]; F.out = args.out;
    F.Win_t = (bf16*)(ws + WS_WIN); F.Wout_t = (bf16*)(ws + WS_WOUT); F.XN = (bf16*)(ws + WS_XN); F.Y = (bf16*)(ws + WS_Y); F.IB = (bf16*)(ws + WS_I); F.rope = (f32x2*)(ws + WS_ROPE); F.ssqp = (float*)(ws + WS_SSQ);
    for (int u = F.tid; u < (LDS_BYTES - LDSCTL_OFF) / 4; u += NWAVES * 64) ((LAS unsigned*)(F.lds + LDSCTL_OFF))[u] = 0u;
    __syncthreads();
    XcdBarrier bar; bar.bar = (unsigned*)(F.ctl + CW_BAR); bar.x = 0; bar.st = nullptr;
    if (N_LAUNCHES == 1) bar = xcd_barrier_post((unsigned*)(F.ctl + CW_BAR), F.MISC + 8);
#define GRID_BAR() do { if (N_LAUNCHES == 1) xcd_barrier(bar); } while (0)
    const int lo = args.ph_lo, hi = args.ph_hi;
#define IN(k) (lo <= (k) && (k) < hi)
#define BOTH(k) (IN(k) && IN((k) + 1))

    if (IN(0)) { p0_prologue(F); if (BOTH(0)) GRID_BAR(); }
#pragma unroll 1
    for (int l = 0; l < DEPTH; ++l) {
        const int pb = 1 + 4 * l;
        if (IN(pb)) {
            pg8::Gemm g{F.XN, F.Win_t + (size_t)l * NIN * D, M, NIN, D}; pg8::StaticOrder S; S.init(M, NIN, F.G, (int)blockIdx.x);
            EpiInProj E{F.IB, F.rope, F.ssqp};
            pg8::gemm_phase<EpiInProj, pg8::StaticOrder, true, true>(F.lds + RING_OFF, g, S, E);
            if (BOTH(pb)) GRID_BAR();
        }
        if (IN(pb + 1)) {
            mixer_a(F, l); mixer_b(F, l); mixer_c(F, l); mixer_d(F, l);
            if (BOTH(pb + 1)) GRID_BAR();
        }
        if (IN(pb + 2)) {
            pg8::Gemm g{F.Y, F.Wout_t + (size_t)l * D * D, M, D, D}; pg8::StaticOrder S; S.init(M, D, F.G, (int)blockIdx.x);
            EpiOutProj E{F.XN, l + 1 < DEPTH ? nullptr : F.out, F.ssqp};
            pg8::gemm_phase<EpiOutProj, pg8::StaticOrder, false, true>(F.lds + RING_OFF, g, S, E);
            if (BOTH(pb + 2)) GRID_BAR();
        }
        if (IN(pb + 3) && l + 1 == DEPTH) {
            const int tid_ = opaque_tid(), lane_ = tid_ & 63, wave_ = __builtin_amdgcn_readfirstlane(tid_ >> 6);
            const int gw = F.vcu * NWAVES + wave_, NGW = F.G * NWAVES;
            for (int m = gw; m < M; m += NGW) rms_row_final(lane_, F.out + (size_t)m * D, F.out + (size_t)m * D, F.final_g, F.ssqp, m);
        }
    }
#undef IN
#undef BOTH
}

extern "C" void kernel_launch(void* const* d_in, const int* in_sizes, int n_in, void* d_out, int out_size, void* d_ws, size_t ws_size, hipStream_t stream) {
    static int grid = 0;
    if (grid == 0) {
        if (n_in != 12 || in_sizes[0] != M * D || out_size != M * D || ws_size < WS_END) { fprintf(stderr, "kernel_launch: unexpected shapes (n_in %d, in0 %d, out %d, ws %zu); nothing launched\n", n_in, n_in > 0 ? in_sizes[0] : -1, out_size, ws_size); grid = -1; return; }
        int dev = 0, cus = 0, per_cu = 0;
        if (hipGetDevice(&dev) != hipSuccess || hipDeviceGetAttribute(&cus, hipDeviceAttributeMultiprocessorCount, dev) != hipSuccess) { grid = -1; return; }
        if (hipFuncSetAttribute((const void*)hymba_fwd, hipFuncAttributeMaxDynamicSharedMemorySize, LDS_BYTES) != hipSuccess) { fprintf(stderr, "kernel_launch: hipFuncSetAttribute failed\n"); grid = -1; return; }
        if (hipOccupancyMaxActiveBlocksPerMultiprocessor(&per_cu, (const void*)hymba_fwd, NWAVES * 64, LDS_BYTES) != hipSuccess || per_cu < 1)
            fprintf(stderr, "kernel_launch: note: occupancy query reports %d workgroups per CU\n", per_cu);
        (void)hipGetLastError();
        grid = cus;
    }
    if (grid < 0) return;
    if (hipMemsetAsync((char*)d_ws + WS_CTL, 0, CTL_ZERO_BYTES, stream) != hipSuccess) return;
    Args a{};
    for (int i = 0; i < 12; ++i) a.in[i] = (const float*)d_in[i];
    a.out = (float*)d_out; a.ws = (unsigned char*)d_ws;
    if (N_LAUNCHES == 1) {
        a.ph_lo = 0; a.ph_hi = N_PHASES; a.li = 0;
        hipLaunchKernelGGL(hymba_fwd, dim3(grid), dim3(NWAVES * 64), LDS_BYTES, stream, a);
    } else {
        for (int li = 0; li < N_PHASES; ++li) { a.ph_lo = li; a.ph_hi = li + 1; a.li = li;
            hipLaunchKernelGGL(hymba_fwd, dim3(grid), dim3(NWAVES * 64), LDS_BYTES, stream, a); }
    }
}
```
